# Optimizing an MI355X kernel written in HIP

```python
import math
import jax, jax.numpy as jnp
from jax import lax
import numpy as np

D_MODEL = 4096
BATCH = 4
SEQ = 2048
DEPTH = 1
DEC_BATCH = 128
DEC_SEQ = 8
PAST_LEN = 16384
PAGE_SIZE = 128

D_MIX = D_MODEL
D_S5 = D_MIX // 2
S5_H = 16
S5_G = D_S5 // S5_H
S5_P = 64
D_SSD = D_MIX - D_S5
SSD_HEADDIM = 64
SSD_HEADS = D_SSD // SSD_HEADDIM
SSD_GROUPS = 8
SSD_STATE = 128
SSD_CONV = 4
SSD_CHUNK = 128
D_XBC = D_SSD + 2 * SSD_GROUPS * SSD_STATE
D_IN = D_S5 + D_SSD + D_XBC + SSD_HEADS
D_FF = ((8 * D_MODEL // 3 + 255) // 256) * 256
FFN_CONV = 3
EPS = 1e-6

kernel_name = "hymba_s5_ssd_convffn_step"


def rmsnorm(x, g):
    xf = x.astype(jnp.float32)
    y = xf * lax.rsqrt(jnp.mean(xf * xf, axis=-1, keepdims=True) + EPS) * g.astype(jnp.float32)
    return y.astype(x.dtype)


def causal_dwconv(x, buf, w, b):
    K = w.shape[0]
    L = x.shape[1]
    xp = jnp.concatenate([buf.astype(x.dtype), x], axis=1)
    out = b + sum(xp[:, k:k + L] * w[k] for k in range(K))
    return out, xp[:, L:]


def _complex_affine_combine(e1, e2):
    a1r, a1i, b1r, b1i = e1
    a2r, a2i, b2r, b2i = e2
    ar = a1r * a2r - a1i * a2i
    ai = a1r * a2i + a1i * a2r
    br = a2r * b1r - a2i * b1i + b2r
    bi = a2r * b1i + a2i * b1r + b2i
    return (ar, ai, br, bi)


def s5_mixer(u, s_re0, s_im0, prm):
    b, L, _ = u.shape
    uf = u.astype(jnp.float32).reshape(b, L, S5_G, S5_H)
    ar = prm['s5_a_re'].astype(jnp.float32)
    ai = prm['s5_a_im'].astype(jnp.float32)
    dt = jnp.exp(prm['s5_log_dt'].astype(jnp.float32))[:, None]
    mag = jnp.exp(ar * dt)
    lbr = mag * jnp.cos(ai * dt)
    lbi = mag * jnp.sin(ai * dt)
    den = ar * ar + ai * ai
    nr = lbr - 1.0
    fr = (nr * ar + lbi * ai) / den
    fi = (lbi * ar - nr * ai) / den
    b_re = prm['s5_b_re'].astype(jnp.float32)
    b_im = prm['s5_b_im'].astype(jnp.float32)
    bbr = fr[..., None] * b_re - fi[..., None] * b_im
    bbi = fr[..., None] * b_im + fi[..., None] * b_re
    bur = jnp.einsum('gph,blgh->blgp', bbr, uf)
    bui = jnp.einsum('gph,blgh->blgp', bbi, uf)
    s_re0 = s_re0.astype(jnp.float32)
    s_im0 = s_im0.astype(jnp.float32)
    bur = bur.at[:, 0].add(lbr * s_re0 - lbi * s_im0)
    bui = bui.at[:, 0].add(lbr * s_im0 + lbi * s_re0)
    a_r = jnp.broadcast_to(lbr, bur.shape)
    a_i = jnp.broadcast_to(lbi, bui.shape)
    _, _, sr, si = lax.associative_scan(_complex_affine_combine, (a_r, a_i, bur, bui), axis=1)
    y = (jnp.einsum('ghp,blgp->blgh', prm['s5_c_re'].astype(jnp.float32), sr)
         - jnp.einsum('ghp,blgp->blgh', prm['s5_c_im'].astype(jnp.float32), si)
         + prm['s5_d'].astype(jnp.float32) * uf)
    y = y.reshape(b, L, D_S5)
    g = jax.nn.gelu(y)
    out = g * jax.nn.sigmoid(g @ prm['s5_w_glu'].astype(jnp.float32) + prm['s5_b_glu'].astype(jnp.float32))
    return out, sr[:, -1], si[:, -1]


def ssd_scan(x, dt, A, Bm, Cm, h0):
    b, L, H, P = x.shape
    rep = H // Bm.shape[2]
    chunk = math.gcd(L, SSD_CHUNK)
    c = L // chunk
    Bh = jnp.repeat(Bm, rep, axis=2).reshape(b, c, chunk, H, -1)
    Ch = jnp.repeat(Cm, rep, axis=2).reshape(b, c, chunk, H, -1)
    xd = (x * dt[..., None]).reshape(b, c, chunk, H, P)
    a = (dt * A).reshape(b, c, chunk, H).transpose(0, 3, 1, 2)
    acs = jnp.cumsum(a, axis=-1)
    mask = jnp.tril(jnp.ones((chunk, chunk), dtype=bool))
    seg = acs[..., :, None] - acs[..., None, :]
    Lmat = jnp.exp(jnp.where(mask, seg, -jnp.inf))
    cb = jnp.einsum('bclhn,bcshn->bhcls', Ch, Bh)
    y_diag = jnp.einsum('bhcls,bcshp->bclhp', cb * Lmat, xd)
    decay_states = jnp.exp(acs[..., -1:] - acs)
    states = jnp.einsum('bcshn,bhcs,bcshp->bchpn', Bh, decay_states, xd)
    chunk_decay = jnp.exp(acs[..., -1])

    def step(h, inp):
        st, dec = inp
        return dec[..., None, None] * h + st, h

    h_final, h_prev = lax.scan(step, h0.astype(jnp.float32),
                               (states.transpose(1, 0, 2, 3, 4), chunk_decay.transpose(2, 0, 1)))
    h_prev = h_prev.transpose(1, 0, 2, 3, 4)
    y_off = jnp.einsum('bclhn,bchpn,bhcl->bclhp', Ch, h_prev, jnp.exp(acs))
    return (y_diag + y_off).reshape(b, L, H, P), h_final


def ssd_mixer(z, xbc, dt_raw, conv0, h0, prm):
    b, L, _ = z.shape
    xbc_c, conv_new = causal_dwconv(xbc, conv0, prm['ssd_conv_w'], prm['ssd_conv_b'])
    xbc_c = jax.nn.silu(xbc_c.astype(jnp.float32))
    gn = SSD_GROUPS * SSD_STATE
    xs = xbc_c[..., :D_SSD].reshape(b, L, SSD_HEADS, SSD_HEADDIM)
    Bm = xbc_c[..., D_SSD:D_SSD + gn].reshape(b, L, SSD_GROUPS, SSD_STATE)
    Cm = xbc_c[..., D_SSD + gn:].reshape(b, L, SSD_GROUPS, SSD_STATE)
    dt = jax.nn.softplus(dt_raw.astype(jnp.float32) + prm['ssd_dt_bias'].astype(jnp.float32))
    A = -jnp.exp(prm['ssd_a_log'].astype(jnp.float32))
    y, h_new = ssd_scan(xs, dt, A, Bm, Cm, h0)
    y = y + prm['ssd_d'].astype(jnp.float32)[:, None] * xs
    y = y.reshape(b, L, D_SSD) * jax.nn.silu(z.astype(jnp.float32))
    yg = y.reshape(b, L, SSD_GROUPS, D_SSD // SSD_GROUPS)
    yg = yg * lax.rsqrt(jnp.mean(yg * yg, axis=-1, keepdims=True) + EPS)
    y = yg.reshape(b, L, D_SSD) * prm['ssd_norm_w'].astype(jnp.float32)
    return y, conv_new, h_new


def layer_step(x, s5_re0, s5_im0, ssd_conv0, ssd_h0, ffn_conv0, prm):
    h = rmsnorm(x, prm['g_mix_pre'])
    proj = h @ prm['w_in']
    u = proj[..., :D_S5]
    z = proj[..., D_S5:D_S5 + D_SSD]
    xbc = proj[..., D_S5 + D_SSD:D_S5 + D_SSD + D_XBC]
    dt_raw = proj[..., D_S5 + D_SSD + D_XBC:]
    y_a, s5_re, s5_im = s5_mixer(u, s5_re0, s5_im0, prm)
    y_b, conv_new, h_new = ssd_mixer(z, xbc, dt_raw, ssd_conv0, ssd_h0, prm)
    mix = jnp.concatenate([y_a, y_b], axis=-1).astype(x.dtype) @ prm['w_out']
    x = x + rmsnorm(mix, prm['g_mix_post'])
    hf = rmsnorm(x, prm['g_ffn_pre'])
    up = hf @ prm['ffn_w_up']
    up_c, ffn_conv_new = causal_dwconv(up, ffn_conv0, prm['ffn_conv_w'], prm['ffn_conv_b'])
    gate, val = up_c[..., :D_FF], up_c[..., D_FF:]
    ff = (jax.nn.gelu(gate, approximate=True) * val) @ prm['ffn_w_down']
    x = x + rmsnorm(ff, prm['g_ffn_post'])
    return x, (s5_re, s5_im, conv_new, h_new, ffn_conv_new)


def setup_inputs(seed: int = 0) -> dict:
    key = jax.random.key(seed)
    nk = iter(jax.random.split(key, 40))
    f32 = jnp.float32

    def nrm(shape, scale=1.0):
        return jax.random.normal(next(nk), shape, f32) * scale

    Dp = (DEPTH,)
    dt0 = jnp.exp(jax.random.uniform(next(nk), Dp + (SSD_HEADS,), f32, math.log(1e-3), math.log(1e-1)))
    return {
        "x_prompt": nrm((BATCH, SEQ, D_MODEL)),
        "x_sample": nrm((DEC_BATCH, DEC_SEQ, D_MODEL)),
        "state_s5_re": nrm(Dp + (DEC_BATCH, S5_G, S5_P), 0.5),
        "state_s5_im": nrm(Dp + (DEC_BATCH, S5_G, S5_P), 0.5),
        "state_ssd_conv": nrm(Dp + (DEC_BATCH, SSD_CONV - 1, D_XBC)),
        "state_ssd": nrm(Dp + (DEC_BATCH, SSD_HEADS, SSD_HEADDIM, SSD_STATE), 0.1),
        "state_ffn_conv": nrm(Dp + (DEC_BATCH, FFN_CONV - 1, 2 * D_FF)),
        "g_mix_pre": 1.0 + nrm(Dp + (D_MODEL,), 0.02),
        "g_mix_post": 1.0 + nrm(Dp + (D_MODEL,), 0.02),
        "g_ffn_pre": 1.0 + nrm(Dp + (D_MODEL,), 0.02),
        "g_ffn_post": 1.0 + nrm(Dp + (D_MODEL,), 0.02),
        "w_in": nrm(Dp + (D_MODEL, D_IN), D_MODEL ** -0.5),
        "s5_a_re": -0.5 + nrm(Dp + (S5_G, S5_P), 0.01),
        "s5_a_im": jnp.pi * jnp.arange(S5_P, dtype=f32) + nrm(Dp + (S5_G, S5_P), 0.01),
        "s5_log_dt": jax.random.uniform(next(nk), Dp + (S5_G,), f32, math.log(1e-3), math.log(1e-1)),
        "s5_b_re": nrm(Dp + (S5_G, S5_P, S5_H), (2 * S5_H) ** -0.5),
        "s5_b_im": nrm(Dp + (S5_G, S5_P, S5_H), (2 * S5_H) ** -0.5),
        "s5_c_re": nrm(Dp + (S5_G, S5_H, S5_P), (2 * S5_P) ** -0.5),
        "s5_c_im": nrm(Dp + (S5_G, S5_H, S5_P), (2 * S5_P) ** -0.5),
        "s5_d": nrm(Dp + (S5_G, S5_H)),
        "s5_w_glu": nrm(Dp + (D_S5, D_S5), D_S5 ** -0.5),
        "s5_b_glu": nrm(Dp + (D_S5,), 0.01),
        "ssd_conv_w": nrm(Dp + (SSD_CONV, D_XBC), SSD_CONV ** -0.5),
        "ssd_conv_b": nrm(Dp + (D_XBC,), 0.01),
        "ssd_dt_bias": dt0 + jnp.log(-jnp.expm1(-dt0)),
        "ssd_a_log": jnp.log(jax.random.uniform(next(nk), Dp + (SSD_HEADS,), f32, 1.0, 16.0)),
        "ssd_d": 1.0 + nrm(Dp + (SSD_HEADS,), 0.1),
        "ssd_norm_w": 1.0 + nrm(Dp + (D_SSD,), 0.02),
        "w_out": nrm(Dp + (D_MIX, D_MODEL), D_MIX ** -0.5),
        "ffn_w_up": nrm(Dp + (D_MODEL, 2 * D_FF), D_MODEL ** -0.5),
        "ffn_conv_w": nrm(Dp + (FFN_CONV, 2 * D_FF), FFN_CONV ** -0.5),
        "ffn_conv_b": nrm(Dp + (2 * D_FF,), 0.01),
        "ffn_w_down": nrm(Dp + (D_FF, D_MODEL), D_FF ** -0.5),
    }


def reference(x_prompt, x_sample, state_s5_re, state_s5_im, state_ssd_conv, state_ssd, state_ffn_conv,
              g_mix_pre, g_mix_post, g_ffn_pre, g_ffn_post, w_in,
              s5_a_re, s5_a_im, s5_log_dt, s5_b_re, s5_b_im, s5_c_re, s5_c_im, s5_d, s5_w_glu, s5_b_glu,
              ssd_conv_w, ssd_conv_b, ssd_dt_bias, ssd_a_log, ssd_d, ssd_norm_w,
              w_out, ffn_w_up, ffn_conv_w, ffn_conv_b, ffn_w_down):
    weights = dict(g_mix_pre=g_mix_pre, g_mix_post=g_mix_post, g_ffn_pre=g_ffn_pre, g_ffn_post=g_ffn_post,
                   w_in=w_in, s5_a_re=s5_a_re, s5_a_im=s5_a_im, s5_log_dt=s5_log_dt,
                   s5_b_re=s5_b_re, s5_b_im=s5_b_im, s5_c_re=s5_c_re, s5_c_im=s5_c_im, s5_d=s5_d,
                   s5_w_glu=s5_w_glu, s5_b_glu=s5_b_glu, ssd_conv_w=ssd_conv_w, ssd_conv_b=ssd_conv_b,
                   ssd_dt_bias=ssd_dt_bias, ssd_a_log=ssd_a_log, ssd_d=ssd_d, ssd_norm_w=ssd_norm_w,
                   w_out=w_out, ffn_w_up=ffn_w_up, ffn_conv_w=ffn_conv_w, ffn_conv_b=ffn_conv_b,
                   ffn_w_down=ffn_w_down)
    bp = x_prompt.shape[0]
    xp, xs = x_prompt, x_sample
    p_states, s_states = [], []
    for l in range(DEPTH):
        prm = {k: v[l] for k, v in weights.items()}
        xp, st_p = layer_step(
            xp,
            jnp.zeros((bp, S5_G, S5_P), jnp.float32),
            jnp.zeros((bp, S5_G, S5_P), jnp.float32),
            jnp.zeros((bp, SSD_CONV - 1, D_XBC), xp.dtype),
            jnp.zeros((bp, SSD_HEADS, SSD_HEADDIM, SSD_STATE), jnp.float32),
            jnp.zeros((bp, FFN_CONV - 1, 2 * D_FF), xp.dtype),
            prm)
        xs, st_s = layer_step(xs, state_s5_re[l], state_s5_im[l], state_ssd_conv[l], state_ssd[l],
                              state_ffn_conv[l], prm)
        p_states.append(st_p)
        s_states.append(st_s)
    p_s5_re, p_s5_im, p_ssd_conv, p_ssd, p_ffn_conv = [jnp.stack([st[i] for st in p_states]) for i in range(5)]
    s_s5_re, s_s5_im, s_ssd_conv, s_ssd, s_ffn_conv = [jnp.stack([st[i] for st in s_states]) for i in range(5)]
    return (xp, xs, p_s5_re, p_s5_im, p_ssd_conv, p_ssd, p_ffn_conv,
            s_s5_re, s_s5_im, s_ssd_conv, s_ssd, s_ffn_conv)
```

```cpp
#include <hip/hip_runtime.h>
#include <cstdio>
#include <cstdint>
namespace pg8 {
#define PG8_LAS __attribute__((address_space(3)))
typedef unsigned short bf16_t;
typedef short bf16x8 __attribute__((ext_vector_type(8)));
typedef float f32x4 __attribute__((ext_vector_type(4)));
typedef unsigned u32x4 __attribute__((ext_vector_type(4)));
constexpr int BM = 256, BK = 64, HALF = 128, HTB = HALF * BK * 2  , STAGE_BYTES = 8 * HTB, NXCD = 8, WGM = 8;

__host__ __device__ __forceinline__ int lds_byte(int r, int c) { const int st = (r >> 4) * 2 + (c >> 5), rr = r & 15, cc = c & 31, ob = rr * 64 + cc * 2; return st * 1024 + (ob ^ (((ob >> 9) & 1) << 5)); }
__host__ __device__ __forceinline__ void stage_rc(int b, int& R, int& C) { const int st = b / 1024, sb = b % 1024, swz = sb ^ (((sb >> 9) & 1) << 5); R = (st >> 1) * 16 + swz / 64; C = (st & 1) * 32 + (swz % 64) / 2; }
__host__ __device__ __forceinline__ int perm32(int rho) { const int n = rho >> 4, i = rho & 15; return 8 * (i >> 2) + 4 * n + (i & 3); }

struct Unit { int pm, pn; };
struct Gemm { const bf16_t* A; const bf16_t* Bt; int M, N, K; };

struct StaticOrder {
    int nM, nN, nwg, G, c;
    __host__ __device__ void init(int M, int N, int G_, int c_) { nM = M / BM; nN = N / BM; nwg = nM * nN; G = G_; c = c_; }
    __host__ __device__ bool next(int i, Unit& u) const {
        const long L = (long)i * G + c; if (L >= nwg) return false;
        int wgid = (int)L; { const int q = nwg / NXCD, r = nwg % NXCD, xcd = wgid % NXCD, off = wgid / NXCD; wgid = (xcd < r ? xcd * (q + 1) : r * (q + 1) + (xcd - r) * q) + off; }
        const int nig = WGM * nN, gid = wgid / nig, fm = gid * WGM, gsz = (nM - fm) < WGM ? (nM - fm) : WGM;
        u.pm = fm + ((wgid % nig) % gsz); u.pn = (wgid % nig) / gsz; return true;
    }
    __device__ __forceinline__ void a_ready(const Unit&) const {}
    __device__ __forceinline__ void done(const Unit&) const {}
};


__device__ __forceinline__ unsigned cvt_pk_bf16(float lo, float hi) { unsigned r; asm volatile("v_cvt_pk_bf16_f32 %0, %1, %2" : "=v"(r) : "v"(lo), "v"(hi)); return r; }
__device__ __forceinline__ u32x4 pack8(const f32x4 v0, const f32x4 v1) { u32x4 w; w.x = cvt_pk_bf16(v0[0], v0[1]); w.y = cvt_pk_bf16(v0[2], v0[3]); w.z = cvt_pk_bf16(v1[0], v1[1]); w.w = cvt_pk_bf16(v1[2], v1[3]); return w; }
__device__ __forceinline__ float bf_lo(unsigned w) { return __uint_as_float(w << 16); }
__device__ __forceinline__ float bf_hi(unsigned w) { return __uint_as_float(w & 0xffff0000u); }

struct EpiStoreBf16 {
    static constexpr bool PERM = true, AFTER_DRAIN = false;
    bf16_t* O; int ldc;
    __device__ __forceinline__ void operator()(const f32x4 (&acc)[2][2][4][2], const Unit& u, int wr, int wc, int fr, int fq) const {
        const int row0 = u.pm * BM + wr * 64 + fr, col0 = u.pn * BM + wc * 32 + 8 * fq;
#pragma unroll
        for (int ai = 0; ai < 2; ++ai)
#pragma unroll
            for (int m = 0; m < 4; ++m) { bf16_t* rowp = O + (size_t)(row0 + ai * HALF + m * 16) * ldc + col0;
#pragma unroll
                for (int bj = 0; bj < 2; ++bj) *(u32x4*)(rowp + bj * HALF) = pack8(acc[ai][bj][m][0], acc[ai][bj][m][1]); }
    }
};
struct EpiProj {
    static constexpr bool PERM = true, AFTER_DRAIN = false;
    bf16_t* UG; bf16_t* Z; bf16_t* XBC; float* DT; int Mrows;
    __device__ __forceinline__ void operator()(const f32x4 (&acc)[2][2][4][2], const Unit& u, int wr, int wc, int fr, int fq) const {
        const int row0 = u.pm * BM + wr * 64 + fr, cl = wc * 32 + 8 * fq;
        if (u.pn < 8) {
#pragma unroll
            for (int ai = 0; ai < 2; ++ai)
#pragma unroll
                for (int m = 0; m < 4; ++m) { const int row = row0 + ai * HALF + m * 16;
#pragma unroll
                    for (int bj = 0; bj < 2; ++bj) { const int col = u.pn * BM + bj * HALF + cl; const int g = col >> 4, h0 = col & 15;
                        *(u32x4*)(UG + ((size_t)g * Mrows + row) * 16 + h0) = pack8(acc[ai][bj][m][0], acc[ai][bj][m][1]); } }
        } else if (u.pn < 32) {
            bf16_t* base = u.pn < 16 ? Z : XBC; const int ldc = u.pn < 16 ? 2048 : 4096; const int colt = (u.pn < 16 ? (u.pn - 8) : (u.pn - 16)) * BM + cl;
#pragma unroll
            for (int ai = 0; ai < 2; ++ai)
#pragma unroll
                for (int m = 0; m < 4; ++m) { bf16_t* rowp = base + (size_t)(row0 + ai * HALF + m * 16) * ldc + colt;
#pragma unroll
                    for (int bj = 0; bj < 2; ++bj) *(u32x4*)(rowp + bj * HALF) = pack8(acc[ai][bj][m][0], acc[ai][bj][m][1]); }
        } else {
            if (wc == 0) {
#pragma unroll
                for (int ai = 0; ai < 2; ++ai)
#pragma unroll
                    for (int m = 0; m < 4; ++m) { float* rowp = DT + (size_t)(row0 + ai * HALF + m * 16) * 32 + 8 * fq;
                        *(f32x4*)(rowp) = acc[ai][0][m][0]; *(f32x4*)(rowp + 4) = acc[ai][0][m][1]; }
            }
        }
    }
};
struct EpiGlu {
    static constexpr bool PERM = true, AFTER_DRAIN = false;
    const bf16_t* G; const float* bias; bf16_t* MIX;
    __device__ __forceinline__ void operator()(const f32x4 (&acc)[2][2][4][2], const Unit& u, int wr, int wc, int fr, int fq) const {
        const int row0 = u.pm * BM + wr * 64 + fr, col0 = u.pn * BM + wc * 32 + 8 * fq;
        f32x4 bv[2][2];
#pragma unroll
        for (int bj = 0; bj < 2; ++bj)
#pragma unroll
            for (int n = 0; n < 2; ++n) bv[bj][n] = *(const f32x4*)(bias + col0 + bj * HALF + 4 * n);
#pragma unroll
        for (int ai = 0; ai < 2; ++ai)
#pragma unroll
            for (int m = 0; m < 4; ++m) { const size_t row = (size_t)(row0 + ai * HALF + m * 16);
#pragma unroll
                for (int bj = 0; bj < 2; ++bj) { const int col = col0 + bj * HALF;
                    const u32x4 gw = *(const u32x4*)(G + row * 2048 + col);
                    f32x4 v0 = acc[ai][bj][m][0] + bv[bj][0], v1 = acc[ai][bj][m][1] + bv[bj][1];
                    f32x4 g0 = (f32x4){bf_lo(gw.x), bf_hi(gw.x), bf_lo(gw.y), bf_hi(gw.y)}, g1 = (f32x4){bf_lo(gw.z), bf_hi(gw.z), bf_lo(gw.w), bf_hi(gw.w)};
#pragma unroll
                    for (int j = 0; j < 4; ++j) { v0[j] = g0[j] / (1.0f + __expf(-v0[j])); v1[j] = g1[j] / (1.0f + __expf(-v1[j])); }
                    *(u32x4*)(MIX + row * 4096 + col) = pack8(v0, v1); } }
    }
};
struct EpiUp {
    static constexpr bool PERM = true, AFTER_DRAIN = false;
    bf16_t* UP; float* pffn; float* sffn;
    __device__ __forceinline__ void operator()(const f32x4 (&acc)[2][2][4][2], const Unit& u, int wr, int wc, int fr, int fq) const {
        const int row0 = u.pm * BM + wr * 64 + fr, col0 = u.pn * BM + wc * 32 + 8 * fq;
#pragma unroll
        for (int ai = 0; ai < 2; ++ai)
#pragma unroll
            for (int m = 0; m < 4; ++m) { const int row = row0 + ai * HALF + m * 16; bf16_t* rowp = UP + (size_t)row * 22016 + col0;
                float* st = nullptr;
                if (row < 8192) { const int t = row & 2047; if (t >= 2046) st = pffn + (size_t)((row >> 11) * 2 + (t - 2046)) * 22016; }
                else { const int r2 = row - 8192, t = r2 & 7; if (t >= 6) st = sffn + (size_t)((r2 >> 3) * 2 + (t - 6)) * 22016; }
#pragma unroll
                for (int bj = 0; bj < 2; ++bj) { *(u32x4*)(rowp + bj * HALF) = pack8(acc[ai][bj][m][0], acc[ai][bj][m][1]);
                    if (st) { *(f32x4*)(st + col0 + bj * HALF) = acc[ai][bj][m][0]; *(f32x4*)(st + col0 + bj * HALF + 4) = acc[ai][bj][m][1]; } } }
    }
};
template <class Epi, class Sched, bool ALIGN_EPI = false, bool SP2 = false>
__device__ __forceinline__ void gemm_phase(PG8_LAS unsigned char* lds, const Gemm g, const Sched& S, const Epi& E) {
    const int tid = threadIdx.x, wid = __builtin_amdgcn_readfirstlane(tid >> 6), lane = tid & 63, wr = wid >> 2, wc = wid & 3, fr = lane & 15, fq = lane >> 4;
    const int K = g.K, nt = K / BK;
    unsigned voffA[2], voffB[2];
#pragma unroll
    for (int i = 0; i < 2; ++i) { int R, C; stage_rc(tid * 16 + i * 8192, R, C); const int Rb = Epi::PERM ? ((R & ~31) + perm32(R & 31)) : R;
        voffA[i] = (unsigned)(R * K + C) * 2u; voffB[i] = (unsigned)(Rb * K + C) * 2u; }
    const size_t kstep = (size_t)(BK * 2);
    const size_t hstep = (size_t)HALF * K * 2;
    const size_t tstep = 2 * hstep;
    const unsigned ldsw = (unsigned)wid * 1024u;
    const int aoff = lds_byte(wr * 64 + fr, fq * 8), boff = lds_byte(wc * 32 + fr, fq * 8);
#define PG8_SA(b, h) (((b) * 2 + (h)) * HTB)
#define PG8_SB(b, h) ((4 + (b) * 2 + (h)) * HTB)
#define PG8_STAGE(bufoff, gbase, voff) do { _Pragma("unroll") for (int _i = 0; _i < 2; ++_i) \
        __builtin_amdgcn_global_load_lds((const unsigned*)((const char*)(gbase) + (voff)[_i]), (PG8_LAS unsigned*)(lds + (bufoff) + ldsw + _i * 8192), 16, 0, 0); } while (0)
#define PG8_LDA(dst, b, h) do { _Pragma("unroll") for (int m = 0; m < 4; ++m) _Pragma("unroll") for (int k = 0; k < 2; ++k) dst[m][k] = *(const PG8_LAS bf16x8*)(lds + PG8_SA(b, h) + aoff + m * 2048 + k * 1024); } while (0)
#define PG8_LDB(dst, b, h) do { _Pragma("unroll") for (int n = 0; n < 2; ++n) _Pragma("unroll") for (int k = 0; k < 2; ++k) dst[n][k] = *(const PG8_LAS bf16x8*)(lds + PG8_SB(b, h) + boff + n * 2048 + k * 1024); } while (0)
#define PG8_MMA(ai, bj, At, Bt) do { __builtin_amdgcn_s_setprio(1); _Pragma("unroll") for (int m = 0; m < 4; ++m) _Pragma("unroll") for (int n = 0; n < 2; ++n) _Pragma("unroll") for (int k = 0; k < 2; ++k) \
        acc[ai][bj][m][n] = __builtin_amdgcn_mfma_f32_16x16x32_bf16(Bt[n][k], At[m][k], acc[ai][bj][m][n], 0, 0, 0); __builtin_amdgcn_s_setprio(0); } while (0)
#define PG8_WAIT_V(n) asm volatile("s_waitcnt vmcnt(" #n ")" ::: "memory")
#define PG8_WAIT_L(n) asm volatile("s_waitcnt lgkmcnt(" #n ")" ::: "memory")
#define PG8_BAR __builtin_amdgcn_s_barrier()
#define PG8_SCHED __builtin_amdgcn_sched_barrier(0)
    Unit cur, nxt; int ui = 0;
    if (!S.next(0, cur)) return;
    f32x4 acc[2][2][4][2];
#pragma unroll
    for (int a = 0; a < 2; ++a)
#pragma unroll
        for (int b = 0; b < 2; ++b)
#pragma unroll
            for (int m = 0; m < 4; ++m)
#pragma unroll
                for (int n = 0; n < 2; ++n) acc[a][b][m][n] = (f32x4){0.f, 0.f, 0.f, 0.f};
    bf16x8 At[4][2], B0[2][2], B1[2][2];
    const char* cA = (const char*)g.A + (size_t)cur.pm * tstep; const char* cB = (const char*)g.Bt + (size_t)cur.pn * tstep;
    S.a_ready(cur);
    if constexpr (SP2) {
        PG8_STAGE(PG8_SB(0, 0), cB, voffB); PG8_STAGE(PG8_SB(0, 1), cB + hstep, voffB); PG8_STAGE(PG8_SA(0, 0), cA, voffA); PG8_STAGE(PG8_SA(0, 1), cA + hstep, voffA);
        if (wr == 1) PG8_BAR;
        PG8_WAIT_V(2); PG8_BAR;
        PG8_STAGE(PG8_SB(1, 0), cB + kstep, voffB); PG8_STAGE(PG8_SA(1, 0), cA + kstep, voffA); PG8_STAGE(PG8_SB(1, 1), cB + hstep + kstep, voffB);
        PG8_WAIT_V(6); PG8_BAR;
    } else {
        PG8_STAGE(PG8_SB(0, 0), cB, voffB); PG8_STAGE(PG8_SA(0, 0), cA, voffA); PG8_STAGE(PG8_SB(0, 1), cB + hstep, voffB); PG8_STAGE(PG8_SA(0, 1), cA + hstep, voffA);
        if (wr == 1) PG8_BAR;
        PG8_WAIT_V(4); PG8_BAR;
        PG8_STAGE(PG8_SB(1, 0), cB + kstep, voffB); PG8_STAGE(PG8_SA(1, 0), cA + kstep, voffA); PG8_STAGE(PG8_SB(1, 1), cB + hstep + kstep, voffB);
        PG8_WAIT_V(6); PG8_BAR;
    }
    for (;;) {
        const bool has_next = S.next(ui + 1, nxt);
        const char* nA = has_next ? (const char*)g.A + (size_t)nxt.pm * tstep : cA; const char* nB = has_next ? (const char*)g.Bt + (size_t)nxt.pn * tstep : cB;
        for (int t = 0; t < nt; t += 2) {
            const bool last = (t == nt - 2);
            const char* a1 = cA + (size_t)(t + 1) * kstep;
            const char* a2 = last ? nA : cA + (size_t)(t + 2) * kstep; const char* b2 = last ? nB : cB + (size_t)(t + 2) * kstep;
            const char* a3 = a2 + kstep; const char* b3 = b2 + kstep;
            if (last && has_next) S.a_ready(nxt);
            if constexpr (SP2) {
            PG8_LDB(B0, 0, 0); PG8_LDB(B1, 0, 1); PG8_SCHED; PG8_LDA(At, 0, 0); PG8_STAGE(PG8_SA(1, 1), a1 + hstep, voffA);
            PG8_WAIT_V(8); PG8_WAIT_L(0); PG8_BAR; PG8_MMA(0, 0, At, B0); PG8_MMA(0, 1, At, B1); PG8_BAR; PG8_SCHED;
            PG8_LDA(At, 0, 1); PG8_STAGE(PG8_SB(0, 0), b2, voffB); PG8_STAGE(PG8_SB(0, 1), b2 + hstep, voffB); PG8_STAGE(PG8_SA(0, 0), a2, voffA);
            PG8_WAIT_V(8); PG8_WAIT_L(0); PG8_BAR; PG8_MMA(1, 0, At, B0); PG8_MMA(1, 1, At, B1); PG8_BAR; PG8_SCHED;
            PG8_LDB(B0, 1, 0); PG8_LDB(B1, 1, 1); PG8_SCHED; PG8_LDA(At, 1, 0); PG8_STAGE(PG8_SA(0, 1), a2 + hstep, voffA);
            PG8_WAIT_V(8); PG8_WAIT_L(0); PG8_BAR; PG8_MMA(0, 0, At, B0); PG8_MMA(0, 1, At, B1); PG8_BAR; PG8_SCHED;
            PG8_LDA(At, 1, 1); PG8_STAGE(PG8_SB(1, 0), b3, voffB); PG8_STAGE(PG8_SB(1, 1), b3 + hstep, voffB); PG8_STAGE(PG8_SA(1, 0), a3, voffA);
            PG8_WAIT_V(8); PG8_WAIT_L(0); PG8_BAR; PG8_MMA(1, 0, At, B0); PG8_MMA(1, 1, At, B1); PG8_BAR; PG8_SCHED;
            } else {
            PG8_LDB(B0, 0, 0); PG8_SCHED; PG8_LDA(At, 0, 0); PG8_STAGE(PG8_SA(1, 1), a1 + hstep, voffA);
            PG8_WAIT_L(8); PG8_BAR; PG8_WAIT_L(0); PG8_MMA(0, 0, At, B0); PG8_BAR; PG8_SCHED;
            PG8_LDB(B1, 0, 1); PG8_STAGE(PG8_SB(0, 0), b2, voffB);
            PG8_BAR; PG8_WAIT_L(0); PG8_MMA(0, 1, At, B1); PG8_BAR;
            PG8_LDA(At, 0, 1); PG8_STAGE(PG8_SA(0, 0), a2, voffA);
            PG8_BAR; PG8_WAIT_L(0); PG8_MMA(1, 0, At, B0); PG8_BAR; PG8_SCHED;
            PG8_STAGE(PG8_SB(0, 1), b2 + hstep, voffB);
            PG8_WAIT_V(6); PG8_BAR; PG8_MMA(1, 1, At, B1); PG8_BAR;
            PG8_LDB(B0, 1, 0); PG8_SCHED; PG8_LDA(At, 1, 0); PG8_STAGE(PG8_SA(0, 1), a2 + hstep, voffA);
            PG8_WAIT_L(8); PG8_BAR; PG8_WAIT_L(0); PG8_MMA(0, 0, At, B0); PG8_BAR; PG8_SCHED;
            PG8_LDB(B1, 1, 1); PG8_STAGE(PG8_SB(1, 0), b3, voffB);
            PG8_BAR; PG8_WAIT_L(0); PG8_MMA(0, 1, At, B1); PG8_BAR;
            PG8_LDA(At, 1, 1); PG8_STAGE(PG8_SA(1, 0), a3, voffA);
            PG8_BAR; PG8_WAIT_L(0); PG8_MMA(1, 0, At, B0); PG8_BAR; PG8_SCHED;
            PG8_STAGE(PG8_SB(1, 1), b3 + hstep, voffB);
            PG8_WAIT_V(6); PG8_BAR; PG8_MMA(1, 1, At, B1); PG8_BAR;
            }
        }
        if constexpr (ALIGN_EPI) { if (wr == 0) PG8_BAR; }
        if constexpr (!Epi::AFTER_DRAIN) { E(acc, cur, wr, wc, fr, fq); S.done(cur); }
        if (!has_next) break;
#pragma unroll
        for (int a = 0; a < 2; ++a)
#pragma unroll
            for (int b = 0; b < 2; ++b)
#pragma unroll
                for (int m = 0; m < 4; ++m)
#pragma unroll
                    for (int n = 0; n < 2; ++n) acc[a][b][m][n] = (f32x4){0.f, 0.f, 0.f, 0.f};
        cur = nxt; cA = nA; cB = nB; ++ui;
        if constexpr (ALIGN_EPI) { if (wr == 1) PG8_BAR; }
    }
    PG8_WAIT_V(0);
    if constexpr (!ALIGN_EPI) { if (wr == 0) PG8_BAR; }
    PG8_BAR;
    if constexpr (Epi::AFTER_DRAIN) { E.fused(acc, cur, wr, wc, fr, fq, lds, wid, lane); S.done(cur); }
#undef PG8_SA
#undef PG8_SB
#undef PG8_STAGE
#undef PG8_LDA
#undef PG8_LDB
#undef PG8_MMA
#undef PG8_WAIT_V
#undef PG8_WAIT_L
#undef PG8_BAR
#undef PG8_SCHED
}
}
#define GAS __attribute__((address_space(1)))
#define LAS __attribute__((address_space(3)))
typedef unsigned short bf16;
typedef unsigned v4u __attribute__((ext_vector_type(4)));
typedef float f32x4 __attribute__((ext_vector_type(4)));
typedef short bf16x8 __attribute__((ext_vector_type(8)));
typedef GAS unsigned gu32;
typedef GAS unsigned long long gu64;
#define RLX_AGENT __ATOMIC_RELAXED, __HIP_MEMORY_SCOPE_AGENT
#define LDS_WAIT() asm volatile("s_waitcnt lgkmcnt(0)" ::: "memory")
#define VM_WAIT() asm volatile("s_waitcnt vmcnt(0)" ::: "memory")
__device__ __forceinline__ unsigned long long rt() { return __builtin_amdgcn_s_memrealtime(); }
__device__ __forceinline__ unsigned f2bf(float f) { unsigned u = __builtin_bit_cast(unsigned, f); return (u + 0x7fffu + ((u >> 16) & 1u)) >> 16; }
__device__ __forceinline__ unsigned pk2(float lo, float hi) { return f2bf(lo) | (f2bf(hi) << 16); }

#define XB_TMO      128
#define XB_XCNT(j)  (256  + 64 * (j))
#define XB_XSUB(j)  (1280 + 64 * (j))
#define XB_XGEN(j)  (2304 + 64 * (j))
#define XB_TOP      3328
#define XB_TOPGEN   3392
#define XCD_BAR_WORDS 3456
#define XB_SPIN_CAP (1u << 18)

__device__ __forceinline__ unsigned xb_ld(unsigned* p)              { return __hip_atomic_load(p, __ATOMIC_RELAXED, __HIP_MEMORY_SCOPE_AGENT); }
__device__ __forceinline__ unsigned xb_add(unsigned* p, unsigned v) { return __hip_atomic_fetch_add(p, v, __ATOMIC_RELAXED, __HIP_MEMORY_SCOPE_AGENT); }
__device__ __forceinline__ unsigned xb_xcc_id() { return (unsigned)__builtin_amdgcn_s_getreg((3 << 11) | 20) & 0xFu; }
#define XB_SPIN(cond, bar) do { unsigned _sp = 0; while (cond) { __builtin_amdgcn_s_sleep(1); \
    if ((++_sp & 255u) == 0u) { if (xb_ld(&(bar)[XB_TMO])) break; if (_sp > XB_SPIN_CAP) { atomicAdd(&(bar)[XB_TMO], 1u); break; } } } } while (0)

struct XcdBarrier {
    unsigned* bar; unsigned x;
    volatile LAS unsigned* st;
};

__device__ __forceinline__ XcdBarrier xcd_barrier_post(unsigned* bar, volatile LAS unsigned* st) {
    XcdBarrier b; b.bar = bar; b.x = xb_xcc_id(); b.st = st;
    if (threadIdx.x == 0) (void)xb_add(&bar[XB_XCNT(b.x)], 1u);
    return b;
}
__device__ __forceinline__ void xcd_barrier_complete(unsigned* bar, unsigned x, unsigned& nloc, unsigned& nx) {
    const unsigned G = gridDim.x * gridDim.y * gridDim.z;
    unsigned sum, cnt, mine, sp = 0u;
    for (;;) {
        sum = 0u; cnt = 0u; mine = 0u;
#pragma unroll
        for (unsigned j = 0; j < 16; ++j) { const unsigned c = xb_ld(&bar[XB_XCNT(j)]); sum += c; cnt += (c > 0u) ? 1u : 0u; mine = (j == x) ? c : mine; }
        if (sum == G) break;
        __builtin_amdgcn_s_sleep(1);
        if ((++sp & 255u) == 0u) { if (xb_ld(&bar[XB_TMO])) break; if (sp > XB_SPIN_CAP) { atomicAdd(&bar[XB_TMO], 1u); break; } }
    }
    nloc = mine > 0u ? mine : 1u; nx = cnt > 0u ? cnt : 1u;
}

__device__ __forceinline__ void xcd_barrier(const XcdBarrier& b) {
    asm volatile("s_waitcnt vmcnt(0)" ::: "memory");
    __syncthreads();
    if (threadIdx.x == 0) {
        unsigned* bar = b.bar;
        __builtin_amdgcn_s_waitcnt(0);
        unsigned nloc = b.st[0], nx = b.st[1];
        if (nloc == 0u) { xcd_barrier_complete(bar, b.x, nloc, nx); b.st[0] = nloc; b.st[1] = nx; }
        const unsigned old = xb_add(&bar[XB_XSUB(b.x)], 1u);
        const unsigned gen = old / nloc;
        if (old + 1u == (gen + 1u) * nloc) {
            __builtin_amdgcn_fence(__ATOMIC_RELEASE, "agent");
            asm volatile("s_waitcnt vmcnt(0)" ::: "memory");
            const unsigned og = xb_add(&bar[XB_TOP], 1u);
            const unsigned tg = og / nx;
            if (og + 1u == (tg + 1u) * nx) xb_add(&bar[XB_TOPGEN], 1u);
            else XB_SPIN(xb_ld(&bar[XB_TOPGEN]) == tg, bar);
            __builtin_amdgcn_fence(__ATOMIC_ACQUIRE, "agent");
            xb_add(&bar[XB_XGEN(b.x)], 1u);
            asm volatile("s_waitcnt vmcnt(0)" ::: "memory");
        } else {
            XB_SPIN(xb_ld(&bar[XB_XGEN(b.x)]) == gen, bar);
            __builtin_amdgcn_fence(__ATOMIC_ACQUIRE, "agent");
            asm volatile("s_waitcnt vmcnt(0)" ::: "memory");
        }
    }
    __syncthreads();
}

constexpr int NWAVES = 8;
constexpr int DM = 4096, MP = 8192, MS = 1024, MROWS = 9216;
constexpr int D_IN = 8224, N1PAD = 8448, D_FF = 11008, N_UP = 22016;
constexpr float EPS = 1e-6f;
#ifndef MK_PH_HI
#define MK_PH_HI 10
#endif
#ifndef MK_N_LAUNCHES
#define MK_N_LAUNCHES 1
#endif
constexpr int N_PHASES = 10;
constexpr size_t O_Y = 0;
constexpr size_t O_PS5RE = (size_t)MROWS * DM;
constexpr size_t O_PS5IM = O_PS5RE + 4 * 128 * 64;
constexpr size_t O_PCONV = O_PS5IM + 4 * 128 * 64;
constexpr size_t O_PSSD  = O_PCONV + 4 * 3 * 4096;
constexpr size_t O_PFFN  = O_PSSD + (size_t)4 * 32 * 64 * 128;
constexpr size_t O_SS5RE = O_PFFN + 4 * 2 * 22016;
constexpr size_t O_SS5IM = O_SS5RE + 128 * 128 * 64;
constexpr size_t O_SCONV = O_SS5IM + 128 * 128 * 64;
constexpr size_t O_SSSD  = O_SCONV + 128 * 3 * 4096;
constexpr size_t O_SFFN  = O_SSSD + (size_t)128 * 32 * 64 * 128;
constexpr size_t O_END   = O_SFFN + (size_t)128 * 2 * 22016;
static_assert(O_END == 81948672, "output size");
constexpr size_t MiB = 1u << 20;
constexpr size_t WS_CTL = 0, CTL_ZERO_BYTES = 1 * MiB;
constexpr size_t WS_LAM = 1 * MiB;
constexpr size_t WS_BBR = 2 * MiB, WS_BBI = 2 * MiB + 512 * 1024;
constexpr size_t WS_KJ  = 3 * MiB;
constexpr size_t WS_DT  = 4 * MiB;
constexpr size_t WS_SSQP = 6 * MiB;
constexpr size_t WS_WUP = 24 * MiB;
constexpr size_t WS_WDN = 196 * MiB;
constexpr size_t WS_HN  = 282 * MiB;
constexpr size_t WS_MIXO = 354 * MiB;
constexpr size_t WS_FF  = 426 * MiB;
constexpr size_t WS_ACT = 498 * MiB;
constexpr size_t WS_WIN = 692 * MiB;
constexpr size_t WS_WGLU = 758 * MiB;
constexpr size_t WS_WOUT = 766 * MiB;
constexpr size_t WS_UG  = 798 * MiB;
constexpr size_t WS_Z   = 834 * MiB;
constexpr size_t WS_XBC = 870 * MiB;
constexpr size_t WS_G   = 942 * MiB;
constexpr size_t WS_MIX = 978 * MiB;
constexpr size_t WS_YG  = 1050 * MiB;
constexpr size_t WS_UP  = 692 * MiB;
constexpr size_t WS_END = 1082 * MiB;
static_assert(WS_UP + (size_t)MROWS * N_UP * 2 <= WS_END && WS_ACT + (size_t)MROWS * D_FF * 2 <= WS_WIN, "ws map");
constexpr int CW_BAR = 4096;
constexpr int RING_BYTES = 131072, MISC_OFF = RING_BYTES + 320, LDS_BYTES = 147456;

struct Frame {
    LAS unsigned char* lds;
    int tid, lane, wave, vcu, G;
};
struct Args { const float* in[33]; float* out; unsigned char* ws; int ph_lo, ph_hi; };
enum { I_XP = 0, I_XS, I_S5RE, I_S5IM, I_SCONV, I_SSSD, I_SFFN, I_GPRE, I_GPOST, I_GFPRE, I_GFPOST, I_WIN, I_ARE, I_AIM, I_LOGDT, I_BRE, I_BIM, I_CRE, I_CIM, I_S5D, I_WGLU, I_BGLU,
       I_CONVW, I_CONVB, I_DTB, I_ALOG, I_SSDD, I_NORMW, I_WOUT, I_WUP, I_FCW, I_FCB, I_WDN };

__device__ __forceinline__ float wave_sum(float v) {
#pragma unroll
    for (int o = 1; o < 64; o <<= 1) v += __shfl_xor(v, o);
    return v;
}
typedef unsigned v2u __attribute__((ext_vector_type(2)));
__device__ __forceinline__ float bf2f(bf16 b) { return __uint_as_float(((unsigned)b) << 16); }
__device__ __forceinline__ void unpack8(const v4u w, float (&o)[8]) {
    o[0] = __uint_as_float(w.x << 16); o[1] = __uint_as_float(w.x & 0xffff0000u); o[2] = __uint_as_float(w.y << 16); o[3] = __uint_as_float(w.y & 0xffff0000u);
    o[4] = __uint_as_float(w.z << 16); o[5] = __uint_as_float(w.z & 0xffff0000u); o[6] = __uint_as_float(w.w << 16); o[7] = __uint_as_float(w.w & 0xffff0000u);
}
__device__ __forceinline__ v4u pack8f(const float (&o)[8]) { v4u w; w.x = pk2(o[0], o[1]); w.y = pk2(o[2], o[3]); w.z = pk2(o[4], o[5]); w.w = pk2(o[6], o[7]); return w; }
__device__ __forceinline__ float silu_f(float v) { return v / (1.0f + __expf(-v)); }
__device__ __forceinline__ float gelu_tanh_f(float v) { const float t = 1.5957691216057308f * (v + 0.044715f * v * v * v); return v / (1.0f + __expf(-t)); }
__device__ __forceinline__ float softplus_f(float v) { return v > 20.f ? v : log1pf(expf(v)); }
__device__ __forceinline__ f32x4 mfma16(bf16x8 a, bf16x8 b, f32x4 c) { return __builtin_amdgcn_mfma_f32_16x16x32_bf16(a, b, c, 0, 0, 0); }

__device__ __forceinline__ void p0_transpose_item(const float* W, int K, int N, bf16* WT, LAS float* scr, int item, int lane) {
    const int nblk = N / 32, kb = item / nblk, nb = item % nblk, k0 = 64 * kb, n0 = 32 * nb;
#pragma unroll 8
    for (int i = 0; i < 32; ++i) { const int kk = 2 * i + (lane >> 5); scr[kk * 33 + (lane & 31)] = W[(size_t)(k0 + kk) * N + n0 + (lane & 31)]; }
    LDS_WAIT(); asm volatile("" ::: "memory");
    const int c = lane & 7;
#pragma unroll
    for (int j = 0; j < 4; ++j) { const int n = (lane >> 3) + 8 * j; const LAS float* s = scr + (8 * c) * 33 + n;
        v4u o; o.x = pk2(s[0 * 33], s[1 * 33]); o.y = pk2(s[2 * 33], s[3 * 33]); o.z = pk2(s[4 * 33], s[5 * 33]); o.w = pk2(s[6 * 33], s[7 * 33]);
        *(GAS v4u*)(WT + (size_t)(n0 + n) * K + k0 + 8 * c) = o; }
    LDS_WAIT(); asm volatile("" ::: "memory");
}
__device__ __forceinline__ void rms_row_to_bf16(const float* xrow, const float* gain, bf16* orow, int lane) {
    const f32x4* xr = (const f32x4*)xrow + lane; const f32x4* gr = (const f32x4*)gain + lane;
    f32x4 v[16]; float s = 0.f;
#pragma unroll
    for (int j = 0; j < 16; ++j) { v[j] = xr[64 * j]; s += (v[j].x * v[j].x + v[j].y * v[j].y) + (v[j].z * v[j].z + v[j].w * v[j].w); }
    const float rstd = 1.0f / sqrtf(wave_sum(s) * (1.f / DM) + EPS);
    unsigned long long* o8 = (unsigned long long*)orow + lane;
#pragma unroll
    for (int j = 0; j < 16; ++j) { const f32x4 g = gr[64 * j]; o8[64 * j] = (unsigned long long)pk2(v[j].x * rstd * g.x, v[j].y * rstd * g.y) | ((unsigned long long)pk2(v[j].z * rstd * g.z, v[j].w * rstd * g.w) << 32); }
}
__device__ __forceinline__ void p0_prologue(Frame& F, const Args& a) {
    unsigned char* ws = a.ws;
    LAS float* scr = (LAS float*)(F.lds + F.wave * 16384);
    const int gw = F.vcu * NWAVES + F.wave, NGW = F.G * NWAVES;
    constexpr int I_IN = (DM / 64) * (D_IN / 32), I_GL = (2048 / 64) * (2048 / 32), I_OUT = (DM / 64) * (DM / 32), I_UPI = (DM / 64) * (N_UP / 32), I_DN = (D_FF / 64) * (DM / 32);
    constexpr int NITEMS = I_IN + I_GL + I_OUT + I_UPI + I_DN;
    for (int it = gw; it < NITEMS; it += NGW) {
        int r = it;
        if (r < I_IN) { p0_transpose_item(a.in[I_WIN], DM, D_IN, (bf16*)(ws + WS_WIN), scr, r, F.lane); continue; } r -= I_IN;
        if (r < I_GL) { p0_transpose_item(a.in[I_WGLU], 2048, 2048, (bf16*)(ws + WS_WGLU), scr, r, F.lane); continue; } r -= I_GL;
        if (r < I_OUT) { p0_transpose_item(a.in[I_WOUT], DM, DM, (bf16*)(ws + WS_WOUT), scr, r, F.lane); continue; } r -= I_OUT;
        if (r < I_UPI) { p0_transpose_item(a.in[I_WUP], DM, N_UP, (bf16*)(ws + WS_WUP), scr, r, F.lane); continue; } r -= I_UPI;
        p0_transpose_item(a.in[I_WDN], D_FF, DM, (bf16*)(ws + WS_WDN), scr, r, F.lane);
    }
    {
        v4u* z = (v4u*)(ws + WS_WIN + (size_t)D_IN * DM * 2); const int nz = (N1PAD - D_IN) * DM * 2 / 16;
        for (int i = gw * 64 + F.lane; i < nz; i += NGW * 64) z[i] = (v4u){0u, 0u, 0u, 0u};
    }
    for (int m = gw; m < MROWS; m += NGW) {
        const float* xrow = m < MP ? a.in[I_XP] + (size_t)m * DM : a.in[I_XS] + (size_t)(m - MP) * DM;
        rms_row_to_bf16(xrow, a.in[I_GPRE], (bf16*)(ws + WS_HN) + (size_t)m * DM, F.lane);
    }
    {
        float2* LAM = (float2*)(ws + WS_LAM); float* BBR = (float*)(ws + WS_BBR); float* BBI = (float*)(ws + WS_BBI);
        for (int i = gw * 64 + F.lane; i < 128 * 64; i += NGW * 64) {
            const int g = i >> 6, p = i & 63;
            const float ar = a.in[I_ARE][i], ai = a.in[I_AIM][i], dt = expf(a.in[I_LOGDT][g]);
            const float mag = expf(ar * dt), th = ai * dt;
            const float lbr = mag * cosf(th), lbi = mag * sinf(th);
            float cr = 1.f, ci = 0.f;
            for (int j = 0; j < 9; ++j) { LAM[(g * 9 + j) * 64 + p] = make_float2(cr, ci); const float nr = cr * lbr - ci * lbi, ni = cr * lbi + ci * lbr; cr = nr; ci = ni; }
            const float den = ar * ar + ai * ai, nr1 = lbr - 1.0f;
            const float fr = (nr1 * ar + lbi * ai) / den, fi = (lbi * ar - nr1 * ai) / den;
            for (int h = 0; h < 16; ++h) { const float br = a.in[I_BRE][i * 16 + h], bi = a.in[I_BIM][i * 16 + h];
                BBR[i * 16 + h] = fr * br - fi * bi; BBI[i * 16 + h] = fr * bi + fi * br; }
        }
    }
}
__device__ __forceinline__ void p1_kj(Frame& F, const Args& a) {
    unsigned char* ws = a.ws;
    const float2* LAM = (const float2*)(ws + WS_LAM); const float* BBR = (const float*)(ws + WS_BBR); const float* BBI = (const float*)(ws + WS_BBI); float* KJ = (float*)(ws + WS_KJ);
    const int gt = (F.vcu * NWAVES + F.wave) * 64 + F.lane, NT = F.G * NWAVES * 64;
    for (int i = gt; i < 128 * 8 * 256; i += NT) {
        const int g = i >> 11, j = (i >> 8) & 7, h = (i >> 4) & 15, hp = i & 15;
        float acc = 0.f;
        for (int p = 0; p < 64; ++p) {
            const float2 L = LAM[(g * 9 + j) * 64 + p]; const float br = BBR[(g * 64 + p) * 16 + hp], bi = BBI[(g * 64 + p) * 16 + hp];
            const float cr = a.in[I_CRE][(g * 16 + h) * 64 + p], ci = a.in[I_CIM][(g * 16 + h) * 64 + p];
            acc += cr * (L.x * br - L.y * bi) - ci * (L.x * bi + L.y * br);
        }
        if (j == 0 && h == hp) acc += a.in[I_S5D][g * 16 + h];
        KJ[i] = acc;
    }
}
__device__ __forceinline__ void s5_unit(Frame& F, const Args& a, int unit) {
    unsigned char* ws = a.ws;
    const int g = unit >> 1, half = unit & 1;
    const int w = F.wave, l = F.lane, c16 = l & 15, q = l >> 4, tid = F.tid;
    LAS float* SL = (LAS float*)(F.lds);
    LAS bf16* SP = (LAS bf16*)(F.lds + 33792);
    const float2* LAM = (const float2*)(ws + WS_LAM); const float* BBR = (const float*)(ws + WS_BBR); const float* BBI = (const float*)(ws + WS_BBI); const float* KJ = (const float*)(ws + WS_KJ);
    const bf16* Ug = (const bf16*)(ws + WS_UG) + (size_t)g * (MROWS * 16);
    bf16* Gout = (bf16*)(ws + WS_G);
    bf16x8 m2f[4], m13f[8];
    {
        const int n = 16 * w + c16, p = n & 63; const bool im = n >= 64;
#pragma unroll
        for (int ks = 0; ks < 4; ++ks) {
            const int tau = 2 * ks + (q >> 1), h0 = 8 * (q & 1);
            const float2 L = LAM[(g * 9 + (7 - tau)) * 64 + p];
            const float* br = BBR + (g * 64 + p) * 16 + h0; const float* bi = BBI + (g * 64 + p) * 16 + h0;
            float v[8];
#pragma unroll
            for (int j = 0; j < 8; ++j) v[j] = im ? (L.x * bi[j] + L.y * br[j]) : (L.x * br[j] - L.y * bi[j]);
            m2f[ks] = __builtin_bit_cast(bf16x8, pack8f(v));
        }
#pragma unroll
        for (int ks = 0; ks < 4; ++ks) {
            const int tau = 2 * ks + (q >> 1), h0 = 8 * (q & 1);
            float v[8];
#pragma unroll
            for (int j = 0; j < 8; ++j) v[j] = (tau <= w) ? KJ[((g * 8 + (w - tau)) * 16 + c16) * 16 + h0 + j] : 0.f;
            m13f[ks] = __builtin_bit_cast(bf16x8, pack8f(v));
        }
#pragma unroll
        for (int ks = 4; ks < 8; ++ks) {
            const int kk = 32 * (ks - 4) + 8 * q, p0 = kk & 63; const bool im2 = kk >= 64;
            float v[8];
#pragma unroll
            for (int j = 0; j < 8; ++j) { const float2 L = LAM[(g * 9 + (w + 1)) * 64 + p0 + j]; const float cr = a.in[I_CRE][(g * 16 + c16) * 64 + p0 + j], ci = a.in[I_CIM][(g * 16 + c16) * 64 + p0 + j];
                v[j] = im2 ? -(cr * L.y + ci * L.x) : (cr * L.x - ci * L.y); }
            m13f[ks] = __builtin_bit_cast(bf16x8, pack8f(v));
        }
    }
    const float2 L8 = LAM[(g * 9 + 8) * 64 + l];
    float sr = 0.f, si = 0.f;
    for (int blk = 0; blk < 9; ++blk) {
        const bool samp = (blk == 8);
        const int bseq = 2 * half + (blk >> 2);
        const int crow0 = samp ? (1024 + 64 * half) : (bseq * 256 + (blk & 3) * 64);
        bf16x8 uf[4][4];
#pragma unroll
        for (int mt = 0; mt < 4; ++mt)
#pragma unroll
            for (int ks = 0; ks < 4; ++ks) uf[mt][ks] = *(const bf16x8*)(Ug + (size_t)(crow0 + 16 * mt + c16) * 128 + 32 * ks + 8 * q);
        f32x4 acc[4];
#pragma unroll
        for (int mt = 0; mt < 4; ++mt) { acc[mt] = (f32x4){0.f, 0.f, 0.f, 0.f};
#pragma unroll
            for (int ks = 0; ks < 4; ++ks) acc[mt] = mfma16(uf[mt][ks], m2f[ks], acc[mt]); }
#pragma unroll
        for (int mt = 0; mt < 4; ++mt)
#pragma unroll
            for (int r = 0; r < 4; ++r) SL[(16 * mt + 4 * q + r) * 132 + 16 * w + c16] = acc[mt][r];
        __syncthreads();
        if (!samp) {
            if (w == 0) {
                if ((blk & 3) == 0) { sr = 0.f; si = 0.f; }
#pragma unroll 8
                for (int r = 0; r < 64; ++r) {
                    SP[r * 136 + l] = (bf16)f2bf(sr); SP[r * 136 + 64 + l] = (bf16)f2bf(si);
                    const float ar = SL[r * 132 + l], ai = SL[r * 132 + 64 + l];
                    const float nr = L8.x * sr - L8.y * si + ar, ni = L8.x * si + L8.y * sr + ai; sr = nr; si = ni;
                }
                if ((blk & 3) == 3) { a.out[O_PS5RE + (size_t)(bseq * 128 + g) * 64 + l] = sr; a.out[O_PS5IM + (size_t)(bseq * 128 + g) * 64 + l] = si; }
            }
        } else {
            for (int idx = tid; idx < 4096; idx += 512) {
                const int r = idx >> 6, p = idx & 63, sb = 64 * half + r;
                const float s0r = a.in[I_S5RE][(size_t)(sb * 128 + g) * 64 + p], s0i = a.in[I_S5IM][(size_t)(sb * 128 + g) * 64 + p];
                SP[r * 136 + p] = (bf16)f2bf(s0r); SP[r * 136 + 64 + p] = (bf16)f2bf(s0i);
                const float2 Lp = LAM[(g * 9 + 8) * 64 + p];
                a.out[O_SS5RE + (size_t)(sb * 128 + g) * 64 + p] = Lp.x * s0r - Lp.y * s0i + SL[r * 132 + p];
                a.out[O_SS5IM + (size_t)(sb * 128 + g) * 64 + p] = Lp.x * s0i + Lp.y * s0r + SL[r * 132 + 64 + p];
            }
        }
        __syncthreads();
#pragma unroll
        for (int mt = 0; mt < 4; ++mt) {
            f32x4 y = (f32x4){0.f, 0.f, 0.f, 0.f};
#pragma unroll
            for (int ks = 0; ks < 4; ++ks) y = mfma16(m13f[ks], uf[mt][ks], y);
#pragma unroll
            for (int ks = 4; ks < 8; ++ks) { const bf16x8 spf = *(const LAS bf16x8*)(SP + (16 * mt + c16) * 136 + 32 * (ks - 4) + 8 * q); y = mfma16(m13f[ks], spf, y); }
            const size_t row = (size_t)8 * (crow0 + 16 * mt + c16) + w;
            const unsigned lo = pk2(gelu_tanh_f(y[0]), gelu_tanh_f(y[1])), hi = pk2(gelu_tanh_f(y[2]), gelu_tanh_f(y[3]));
            *(unsigned long long*)(Gout + row * 2048 + g * 16 + 4 * q) = (unsigned long long)lo | ((unsigned long long)hi << 32);
        }
        __syncthreads();
    }
}
__device__ __forceinline__ void ssd_prompt_unit(Frame& F, const Args& a, int unit) {
    unsigned char* ws = a.ws;
    const int b = unit >> 6, head = (unit >> 1) & 31, ph = unit & 1, grp = head >> 2;
    const int w = F.wave, l = F.lane, c16 = l & 15, q = l >> 4, tid = F.tid;
    LAS bf16* Bc  = (LAS bf16*)(F.lds);
    LAS bf16* Bct = (LAS bf16*)(F.lds + 34816);
    LAS bf16* Cc  = (LAS bf16*)(F.lds + 69632);
    LAS bf16* Xt  = (LAS bf16*)(F.lds + 104448);
    LAS bf16* Hb  = (LAS bf16*)(F.lds + 113152);
    LAS float* DTs = (LAS float*)(F.lds + 121856);
    LAS float* ACS = DTs + 128; LAS float* WGT = ACS + 128;
    const bf16* XBC = (const bf16*)(ws + WS_XBC); const bf16* Zb = (const bf16*)(ws + WS_Z); const float* DT = (const float*)(ws + WS_DT);
    bf16* YG = (bf16*)(ws + WS_YG); float* SSQP = (float*)(ws + WS_SSQP);
    const float* cw = a.in[I_CONVW]; const float* cbias = a.in[I_CONVB];
    const float Ah = -expf(a.in[I_ALOG][head]), Dh = a.in[I_SSDD][head], dtb = a.in[I_DTB][head];
    const bool wr_bc = ((head & 3) == 0) && (ph == 0);
    for (int i = tid; i < 32 * 136; i += 512) Hb[i] = 0;
    f32x4 Hacc[2] = {(f32x4){0.f, 0.f, 0.f, 0.f}, (f32x4){0.f, 0.f, 0.f, 0.f}};
    __syncthreads();
    for (int c = 0; c < 16; ++c) {
        const int row0 = b * 2048 + 128 * c;
#pragma unroll 1
        for (int it = 0; it < 9; ++it) {
            int o, t, col, kind;
            if (it < 4) { const int idx = it * 512 + tid; o = idx & 15; t = idx >> 4; col = 2048 + grp * 128 + 8 * o; kind = 1; }
            else if (it < 8) { const int idx = (it - 4) * 512 + tid; o = idx & 15; t = idx >> 4; col = 3072 + grp * 128 + 8 * o; kind = 2; }
            else { o = tid & 3; t = tid >> 2; col = head * 64 + ph * 32 + 8 * o; kind = 0; }
            float v[8], rl[8];
            { const f32x4 b0 = *(const f32x4*)(cbias + col), b1 = *(const f32x4*)(cbias + col + 4); v[0] = b0.x; v[1] = b0.y; v[2] = b0.z; v[3] = b0.w; v[4] = b1.x; v[5] = b1.y; v[6] = b1.z; v[7] = b1.w; }
#pragma unroll
            for (int k = 0; k < 4; ++k) {
                const int tk = 128 * c + t - 3 + k;
                if (tk >= 0) { unpack8(*(const v4u*)(XBC + (size_t)(b * 2048 + tk) * 4096 + col), rl);
                    const f32x4 w0 = *(const f32x4*)(cw + k * 4096 + col), w1 = *(const f32x4*)(cw + k * 4096 + col + 4);
                    v[0] += w0.x * rl[0]; v[1] += w0.y * rl[1]; v[2] += w0.z * rl[2]; v[3] += w0.w * rl[3]; v[4] += w1.x * rl[4]; v[5] += w1.y * rl[5]; v[6] += w1.z * rl[6]; v[7] += w1.w * rl[7]; }
            }
            if (c == 15 && t >= 125 && (kind == 0 || wr_bc)) {
                float* dst = a.out + O_PCONV + (size_t)(b * 3 + (t - 125)) * 4096 + col;
                *(f32x4*)dst = (f32x4){rl[0], rl[1], rl[2], rl[3]}; *(f32x4*)(dst + 4) = (f32x4){rl[4], rl[5], rl[6], rl[7]};
            }
#pragma unroll
            for (int j = 0; j < 8; ++j) v[j] = silu_f(v[j]);
            const v4u pk = pack8f(v);
            if (kind == 1) { *(LAS v4u*)(Bc + t * 136 + 8 * o) = pk;
#pragma unroll
                for (int j = 0; j < 8; ++j) Bct[(8 * o + j) * 136 + t] = (bf16)f2bf(v[j]); }
            else if (kind == 2) { *(LAS v4u*)(Cc + t * 136 + 8 * o) = pk; }
            else {
#pragma unroll
                for (int j = 0; j < 8; ++j) Xt[(8 * o + j) * 136 + t] = (bf16)f2bf(v[j]); }
        }
        if (w == 0) {
            const float d0 = softplus_f(DT[(size_t)(row0 + 2 * l) * 32 + head] + dtb), d1 = softplus_f(DT[(size_t)(row0 + 2 * l + 1) * 32 + head] + dtb);
            const float a0 = d0 * Ah, a1 = d1 * Ah, s = a0 + a1; float incl = s;
#pragma unroll
            for (int off = 1; off < 64; off <<= 1) { const float vv = __shfl_up(incl, off); if (l >= off) incl += vv; }
            const float ac0 = incl - s + a0, ac1 = incl, last = __shfl(incl, 63);
            DTs[2 * l] = d0; DTs[2 * l + 1] = d1; ACS[2 * l] = ac0; ACS[2 * l + 1] = ac1; WGT[2 * l] = __expf(last - ac0) * d0; WGT[2 * l + 1] = __expf(last - ac1) * d1;
        }
        __syncthreads();
        bf16x8 cf[4];
#pragma unroll
        for (int ks = 0; ks < 4; ++ks) cf[ks] = *(const LAS bf16x8*)(Cc + (16 * w + c16) * 136 + 32 * ks + 8 * q);
        f32x4 cbt[8];
#pragma unroll
        for (int T = 0; T < 8; ++T) { cbt[T] = (f32x4){0.f, 0.f, 0.f, 0.f};
            if (T <= w) {
#pragma unroll
                for (int ks = 0; ks < 4; ++ks) { const bf16x8 bfr = *(const LAS bf16x8*)(Bc + (16 * T + c16) * 136 + 32 * ks + 8 * q); cbt[T] = mfma16(bfr, cf[ks], cbt[T]); } } }
        const int lrow = 16 * w + c16; const float acl = ACS[lrow];
        f32x4 yd[2] = {(f32x4){0.f, 0.f, 0.f, 0.f}, (f32x4){0.f, 0.f, 0.f, 0.f}}, yo[2] = {(f32x4){0.f, 0.f, 0.f, 0.f}, (f32x4){0.f, 0.f, 0.f, 0.f}};
#pragma unroll
        for (int Tp = 0; Tp < 4; ++Tp) {
            if (2 * Tp <= w) {
                float e[8];
#pragma unroll
                for (int hf = 0; hf < 2; ++hf) { const int T = 2 * Tp + hf; const int s0 = 16 * T + 4 * q;
                    const f32x4 as = *(const LAS f32x4*)(ACS + s0), ds = *(const LAS f32x4*)(DTs + s0);
#pragma unroll
                    for (int r = 0; r < 4; ++r) e[4 * hf + r] = (s0 + r <= lrow) ? cbt[T][r] * __expf(acl - as[r]) * ds[r] : 0.f; }
                const bf16x8 wf = __builtin_bit_cast(bf16x8, pack8f(e));
#pragma unroll
                for (int pt = 0; pt < 2; ++pt) {
                    const v2u lo = *(const LAS v2u*)(Xt + (16 * pt + c16) * 136 + 32 * Tp + 4 * q), hi = *(const LAS v2u*)(Xt + (16 * pt + c16) * 136 + 32 * Tp + 16 + 4 * q);
                    const v4u xv = (v4u){lo.x, lo.y, hi.x, hi.y};
                    yd[pt] = mfma16(wf, __builtin_bit_cast(bf16x8, xv), yd[pt]); }
            }
        }
#pragma unroll
        for (int pt = 0; pt < 2; ++pt)
#pragma unroll
            for (int ks = 0; ks < 4; ++ks) { const bf16x8 hfr = *(const LAS bf16x8*)(Hb + (16 * pt + c16) * 136 + 32 * ks + 8 * q); yo[pt] = mfma16(cf[ks], hfr, yo[pt]); }
#pragma unroll
        for (int r = 0; r < 4; ++r) {
            const int lr = 16 * w + 4 * q + r; const float ea = __expf(ACS[lr]); const size_t rowg = (size_t)(row0 + lr); float ss = 0.f;
#pragma unroll
            for (int pt = 0; pt < 2; ++pt) { const int p = 16 * pt + c16; const float xv = bf2f(Xt[p * 136 + lr]);
                const float y = yd[pt][r] + ea * yo[pt][r] + Dh * xv; const float zv = bf2f(Zb[rowg * 2048 + head * 64 + ph * 32 + p]);
                const float yg = y * silu_f(zv); ss += yg * yg; YG[rowg * 2048 + head * 64 + ph * 32 + p] = (bf16)f2bf(yg); }
            ss += __shfl_xor(ss, 1); ss += __shfl_xor(ss, 2); ss += __shfl_xor(ss, 4); ss += __shfl_xor(ss, 8);
            if (c16 == 0) SSQP[rowg * 64 + head * 2 + ph] = ss;
        }
        __syncthreads();
        {
            const float dec = __expf(ACS[127]);
            Hacc[0] = Hacc[0] * dec; Hacc[1] = Hacc[1] * dec;
#pragma unroll
            for (int ks = 0; ks < 4; ++ks) {
                const bf16x8 bfr = *(const LAS bf16x8*)(Bct + (16 * w + c16) * 136 + 32 * ks + 8 * q);
                const f32x4 g0 = *(const LAS f32x4*)(WGT + 32 * ks + 8 * q), g1 = *(const LAS f32x4*)(WGT + 32 * ks + 8 * q + 4);
#pragma unroll
                for (int pt = 0; pt < 2; ++pt) { float xr[8]; unpack8(*(const LAS v4u*)(Xt + (16 * pt + c16) * 136 + 32 * ks + 8 * q), xr);
                    xr[0] *= g0.x; xr[1] *= g0.y; xr[2] *= g0.z; xr[3] *= g0.w; xr[4] *= g1.x; xr[5] *= g1.y; xr[6] *= g1.z; xr[7] *= g1.w;
                    Hacc[pt] = mfma16(__builtin_bit_cast(bf16x8, pack8f(xr)), bfr, Hacc[pt]); }
            }
#pragma unroll
            for (int pt = 0; pt < 2; ++pt)
#pragma unroll
                for (int r = 0; r < 4; ++r) Hb[(16 * pt + 4 * q + r) * 136 + 16 * w + c16] = (bf16)f2bf(Hacc[pt][r]);
            if (c == 15) {
#pragma unroll
                for (int pt = 0; pt < 2; ++pt)
#pragma unroll
                    for (int r = 0; r < 4; ++r) a.out[O_PSSD + ((size_t)(b * 32 + head) * 64 + ph * 32 + 16 * pt + 4 * q + r) * 128 + 16 * w + c16] = Hacc[pt][r];
            }
        }
        __syncthreads();
    }
}
__device__ __forceinline__ void ssd_sample_unit(Frame& F, const Args& a, int unit) {
    unsigned char* ws = a.ws;
    const int sb = unit >> 3, grp = unit & 7;
    const int w = F.wave, l = F.lane, c16 = l & 15, q = l >> 4, tid = F.tid;
    LAS float* XS = (LAS float*)(F.lds);
    LAS float* BS = XS + 2048;
    LAS float* CS = BS + 1024;
    LAS float* YS = CS + 1024;
    LAS float* DTS = YS + 2048;
    LAS float* DAS = DTS + 32;
    const bf16* XBC = (const bf16*)(ws + WS_XBC); const bf16* Zb = (const bf16*)(ws + WS_Z); const float* DT = (const float*)(ws + WS_DT);
    bf16* MIX = (bf16*)(ws + WS_MIX);
    const int R0 = MP + 8 * sb;
    {
        const int ch = tid; const int col = ch < 256 ? grp * 256 + ch : (ch < 384 ? 2048 + grp * 128 + (ch - 256) : 3072 + grp * 128 + (ch - 384));
        const float* cw = a.in[I_CONVW]; const float w0 = cw[col], w1 = cw[4096 + col], w2 = cw[8192 + col], w3 = cw[12288 + col], cb = a.in[I_CONVB][col];
        const float* st = a.in[I_SCONV] + (size_t)sb * 3 * 4096 + col;
        float r0 = st[0], r1 = st[4096], r2 = st[8192];
        LAS float* dst = ch < 256 ? XS + ch : (ch < 384 ? BS + (ch - 256) : CS + (ch - 384)); const int pitch = ch < 256 ? 256 : 128;
#pragma unroll
        for (int t = 0; t < 8; ++t) { const float r3 = bf2f(XBC[(size_t)(R0 + t) * 4096 + col]);
            dst[t * pitch] = silu_f(cb + w0 * r0 + w1 * r1 + w2 * r2 + w3 * r3);
            if (t >= 5) a.out[O_SCONV + (size_t)(sb * 3 + (t - 5)) * 4096 + col] = r3;
            r0 = r1; r1 = r2; r2 = r3; }
        if (tid < 32) { const int t = tid >> 2, hl = tid & 3, head = grp * 4 + hl; const float d = softplus_f(DT[(size_t)(R0 + t) * 32 + head] + a.in[I_DTB][head]);
            DTS[tid] = d; DAS[tid] = __expf(-d * expf(a.in[I_ALOG][head])); }
    }
    __syncthreads();
    {
        const int hl = w >> 1, head = grp * 4 + hl, pbase = 32 * (w & 1);
        const float Dh = a.in[I_SSDD][head];
        f32x4 H[2][8];
        const float* hin = a.in[I_SSSD] + (size_t)(sb * 32 + head) * 64 * 128; float* hout = a.out + O_SSSD + (size_t)(sb * 32 + head) * 64 * 128;
#pragma unroll
        for (int pt = 0; pt < 2; ++pt)
#pragma unroll
            for (int ks = 0; ks < 8; ++ks) H[pt][ks] = *(const f32x4*)(hin + (size_t)(pbase + 16 * pt + c16) * 128 + 16 * ks + 4 * q);
#pragma unroll 1
        for (int t = 0; t < 8; ++t) {
            const float dA = DAS[t * 4 + hl], dtv = DTS[t * 4 + hl];
            const float x0 = XS[t * 256 + hl * 64 + pbase + c16], x1 = XS[t * 256 + hl * 64 + pbase + 16 + c16];
            const float xd0 = x0 * dtv, xd1 = x1 * dtv; float y0 = 0.f, y1 = 0.f;
#pragma unroll
            for (int ks = 0; ks < 8; ++ks) { const f32x4 b4 = *(const LAS f32x4*)(BS + t * 128 + 16 * ks + 4 * q), c4 = *(const LAS f32x4*)(CS + t * 128 + 16 * ks + 4 * q);
                H[0][ks] = H[0][ks] * dA + b4 * xd0; H[1][ks] = H[1][ks] * dA + b4 * xd1;
                y0 += (c4.x * H[0][ks].x + c4.y * H[0][ks].y) + (c4.z * H[0][ks].z + c4.w * H[0][ks].w);
                y1 += (c4.x * H[1][ks].x + c4.y * H[1][ks].y) + (c4.z * H[1][ks].z + c4.w * H[1][ks].w); }
            y0 += __shfl_xor(y0, 16); y0 += __shfl_xor(y0, 32); y1 += __shfl_xor(y1, 16); y1 += __shfl_xor(y1, 32);
            if (q == 0) {
                const size_t zoff = (size_t)(R0 + t) * 2048 + head * 64 + pbase + c16;
                const float z0 = bf2f(Zb[zoff]), z1 = bf2f(Zb[zoff + 16]);
                YS[t * 256 + hl * 64 + pbase + c16] = (y0 + Dh * x0) * silu_f(z0); YS[t * 256 + hl * 64 + pbase + 16 + c16] = (y1 + Dh * x1) * silu_f(z1);
            }
        }
#pragma unroll
        for (int pt = 0; pt < 2; ++pt)
#pragma unroll
            for (int ks = 0; ks < 8; ++ks) *(f32x4*)(hout + (size_t)(pbase + 16 * pt + c16) * 128 + 16 * ks + 4 * q) = H[pt][ks];
    }
    __syncthreads();
    {
        const f32x4 yv = *(const LAS f32x4*)(YS + w * 256 + 4 * l);
        const float ss = wave_sum((yv.x * yv.x + yv.y * yv.y) + (yv.z * yv.z + yv.w * yv.w));
        const float rstd = 1.0f / sqrtf(ss * (1.f / 256.f) + EPS);
        const f32x4 nw = *(const f32x4*)(a.in[I_NORMW] + grp * 256 + 4 * l);
        *(unsigned long long*)(MIX + (size_t)(R0 + w) * 4096 + 2048 + grp * 256 + 4 * l) = (unsigned long long)pk2(yv.x * rstd * nw.x, yv.y * rstd * nw.y) | ((unsigned long long)pk2(yv.z * rstd * nw.z, yv.w * rstd * nw.w) << 32);
    }
    __syncthreads();
}
__device__ __forceinline__ void p3_ssd_norm(Frame& F, const Args& a) {
    unsigned char* ws = a.ws;
    const bf16* YG = (const bf16*)(ws + WS_YG); const float* SSQP = (const float*)(ws + WS_SSQP); bf16* MIX = (bf16*)(ws + WS_MIX);
    const int gw = F.vcu * NWAVES + F.wave, NGW = F.G * NWAVES, l = F.lane;
    for (int m = gw; m < MP; m += NGW) {
#pragma unroll
        for (int i = 0; i < 4; ++i) {
            const int c = 8 * (l + 64 * i), grp = c >> 8;
            const f32x4 s0 = *(const f32x4*)(SSQP + (size_t)m * 64 + grp * 8), s1 = *(const f32x4*)(SSQP + (size_t)m * 64 + grp * 8 + 4);
            const float rstd = 1.0f / sqrtf(((s0.x + s0.y) + (s0.z + s0.w) + (s1.x + s1.y) + (s1.z + s1.w)) * (1.f / 256.f) + EPS);
            float v[8]; unpack8(*(const v4u*)(YG + (size_t)m * 2048 + c), v);
            const f32x4 n0 = *(const f32x4*)(a.in[I_NORMW] + c), n1 = *(const f32x4*)(a.in[I_NORMW] + c + 4);
            v[0] *= rstd * n0.x; v[1] *= rstd * n0.y; v[2] *= rstd * n0.z; v[3] *= rstd * n0.w; v[4] *= rstd * n1.x; v[5] *= rstd * n1.y; v[6] *= rstd * n1.z; v[7] *= rstd * n1.w;
            *(v4u*)(MIX + (size_t)m * 4096 + 2048 + c) = pack8f(v);
        }
    }
}
__device__ __forceinline__ void p5_rows(Frame& F, const Args& a) {
    unsigned char* ws = a.ws;
    const bf16* MIXO = (const bf16*)(ws + WS_MIXO); bf16* HN = (bf16*)(ws + WS_HN);
    const int gw = F.vcu * NWAVES + F.wave, NGW = F.G * NWAVES, l = F.lane;
    for (int m = gw; m < MROWS; m += NGW) {
        const float* xrow = m < MP ? a.in[I_XP] + (size_t)m * DM : a.in[I_XS] + (size_t)(m - MP) * DM;
        f32x4 v[16]; float s = 0.f;
#pragma unroll
        for (int j = 0; j < 16; ++j) { const v2u mw = *(const v2u*)(MIXO + (size_t)m * DM + 4 * (l + 64 * j));
            v[j] = (f32x4){__uint_as_float(mw.x << 16), __uint_as_float(mw.x & 0xffff0000u), __uint_as_float(mw.y << 16), __uint_as_float(mw.y & 0xffff0000u)};
            s += (v[j].x * v[j].x + v[j].y * v[j].y) + (v[j].z * v[j].z + v[j].w * v[j].w); }
        const float rstd1 = 1.0f / sqrtf(wave_sum(s) * (1.f / DM) + EPS); float s2 = 0.f;
#pragma unroll
        for (int j = 0; j < 16; ++j) { const f32x4 xv = ((const f32x4*)xrow)[l + 64 * j], g = ((const f32x4*)a.in[I_GPOST])[l + 64 * j];
            v[j] = xv + v[j] * rstd1 * g; s2 += (v[j].x * v[j].x + v[j].y * v[j].y) + (v[j].z * v[j].z + v[j].w * v[j].w);
            ((f32x4*)(a.out + O_Y + (size_t)m * DM))[l + 64 * j] = v[j]; }
        const float rstd2 = 1.0f / sqrtf(wave_sum(s2) * (1.f / DM) + EPS);
        unsigned long long* o8 = (unsigned long long*)(HN + (size_t)m * DM) + l;
#pragma unroll
        for (int j = 0; j < 16; ++j) { const f32x4 g = ((const f32x4*)a.in[I_GFPRE])[l + 64 * j];
            o8[64 * j] = (unsigned long long)pk2(v[j].x * rstd2 * g.x, v[j].y * rstd2 * g.y) | ((unsigned long long)pk2(v[j].z * rstd2 * g.z, v[j].w * rstd2 * g.w) << 32); }
    }
}
__device__ __forceinline__ void p7_conv_geglu(Frame& F, const Args& a) {
    unsigned char* ws = a.ws;
    const bf16* UP = (const bf16*)(ws + WS_UP); bf16* ACT = (bf16*)(ws + WS_ACT);
    const float* cw = a.in[I_FCW]; const float* cb = a.in[I_FCB];
    const int gt = (F.vcu * NWAVES + F.wave) * 64 + F.lane, NT = F.G * NWAVES * 64;
    constexpr int NOC = D_FF / 8;
#pragma unroll 1
    for (int idx = gt; idx < (MROWS / 8) * NOC; idx += NT) {
        const int rb = idx / NOC, oc = idx - rb * NOC, col = 8 * oc, row0 = 8 * rb;
        float g2[8], g1[8], v2[8], v1[8];
        if (row0 >= MP) { const float* st = a.in[I_SFFN] + (size_t)((row0 - MP) >> 3) * 2 * N_UP;
#pragma unroll
            for (int j = 0; j < 8; ++j) { g2[j] = st[col + j]; g1[j] = st[N_UP + col + j]; v2[j] = st[D_FF + col + j]; v1[j] = st[N_UP + D_FF + col + j]; } }
        else if ((row0 & 2047) == 0) {
#pragma unroll
            for (int j = 0; j < 8; ++j) { g2[j] = 0.f; g1[j] = 0.f; v2[j] = 0.f; v1[j] = 0.f; } }
        else { unpack8(*(const v4u*)(UP + (size_t)(row0 - 2) * N_UP + col), g2); unpack8(*(const v4u*)(UP + (size_t)(row0 - 1) * N_UP + col), g1);
               unpack8(*(const v4u*)(UP + (size_t)(row0 - 2) * N_UP + D_FF + col), v2); unpack8(*(const v4u*)(UP + (size_t)(row0 - 1) * N_UP + D_FF + col), v1); }
        float wg[3][8], wv[3][8], bg[8], bv[8];
#pragma unroll
        for (int j = 0; j < 8; ++j) { bg[j] = cb[col + j]; bv[j] = cb[D_FF + col + j];
#pragma unroll
            for (int k = 0; k < 3; ++k) { wg[k][j] = cw[k * N_UP + col + j]; wv[k][j] = cw[k * N_UP + D_FF + col + j]; } }
#pragma unroll 2
        for (int r = 0; r < 8; ++r) {
            float g0[8], v0[8], o[8];
            unpack8(*(const v4u*)(UP + (size_t)(row0 + r) * N_UP + col), g0); unpack8(*(const v4u*)(UP + (size_t)(row0 + r) * N_UP + D_FF + col), v0);
#pragma unroll
            for (int j = 0; j < 8; ++j) { const float gate = bg[j] + wg[0][j] * g2[j] + wg[1][j] * g1[j] + wg[2][j] * g0[j]; const float val = bv[j] + wv[0][j] * v2[j] + wv[1][j] * v1[j] + wv[2][j] * v0[j];
                o[j] = gelu_tanh_f(gate) * val; g2[j] = g1[j]; g1[j] = g0[j]; v2[j] = v1[j]; v1[j] = v0[j]; }
            *(v4u*)(ACT + (size_t)(row0 + r) * D_FF + col) = pack8f(o);
        }
    }
}
__device__ __forceinline__ void p9_rows(Frame& F, const Args& a) {
    unsigned char* ws = a.ws;
    const bf16* FFb = (const bf16*)(ws + WS_FF);
    const int gw = F.vcu * NWAVES + F.wave, NGW = F.G * NWAVES, l = F.lane;
    for (int m = gw; m < MROWS; m += NGW) {
        f32x4 v[16]; float s = 0.f;
#pragma unroll
        for (int j = 0; j < 16; ++j) { const v2u mw = *(const v2u*)(FFb + (size_t)m * DM + 4 * (l + 64 * j));
            v[j] = (f32x4){__uint_as_float(mw.x << 16), __uint_as_float(mw.x & 0xffff0000u), __uint_as_float(mw.y << 16), __uint_as_float(mw.y & 0xffff0000u)};
            s += (v[j].x * v[j].x + v[j].y * v[j].y) + (v[j].z * v[j].z + v[j].w * v[j].w); }
        const float rstd = 1.0f / sqrtf(wave_sum(s) * (1.f / DM) + EPS);
        f32x4* orow = (f32x4*)(a.out + O_Y + (size_t)m * DM);
#pragma unroll
        for (int j = 0; j < 16; ++j) { const f32x4 g = ((const f32x4*)a.in[I_GFPOST])[l + 64 * j]; orow[l + 64 * j] = orow[l + 64 * j] + v[j] * rstd * g; }
    }
}

__global__ void __launch_bounds__(NWAVES * 64, 2) mk_fwd(Args args) {
    extern __shared__ __attribute__((aligned(16))) unsigned char lds[];
    Frame F;
    F.lds = (LAS unsigned char*)lds;
    volatile LAS unsigned* MISC = (volatile LAS unsigned*)(F.lds + MISC_OFF);
    F.tid = threadIdx.x; F.lane = F.tid & 63; F.wave = __builtin_amdgcn_readfirstlane(F.tid >> 6);
    F.G = gridDim.x; { const int bx = blockIdx.x; F.vcu = (F.G % 8 == 0) ? (bx % 8) * (F.G / 8) + bx / 8 : bx; }
    unsigned char* ws = args.ws;
    unsigned* ctl = (unsigned*)(ws + WS_CTL);
    for (int u = F.tid; u < (LDS_BYTES - RING_BYTES) / 4; u += NWAVES * 64) ((LAS unsigned*)(F.lds + RING_BYTES))[u] = 0u;
    __syncthreads();
    XcdBarrier bar = xcd_barrier_post(ctl + CW_BAR, MISC + 8);
    const int lo = args.ph_lo, hi = args.ph_hi;
#define IN(k) (lo <= (k) && (k) < hi)
#define SEAM(k) do { if (IN(k) && IN((k) + 1)) xcd_barrier(bar); } while (0)

    if (IN(0)) { p0_prologue(F, args); } SEAM(0);
    if (IN(1)) {
        p1_kj(F, args);
        pg8::Gemm g{(const pg8::bf16_t*)(ws + WS_HN), (const pg8::bf16_t*)(ws + WS_WIN), MROWS, N1PAD, DM}; pg8::StaticOrder S; S.init(MROWS, N1PAD, F.G, (int)blockIdx.x);
        pg8::EpiProj E{(pg8::bf16_t*)(ws + WS_UG), (pg8::bf16_t*)(ws + WS_Z), (pg8::bf16_t*)(ws + WS_XBC), (float*)(ws + WS_DT), MROWS};
        pg8::gemm_phase<pg8::EpiProj, pg8::StaticOrder, true, true>(F.lds, g, S, E);
    } SEAM(1);
    if (IN(2)) {
        for (int u = blockIdx.x; u < 256; u += F.G) s5_unit(F, args, u);
        for (int u = blockIdx.x; u < 256; u += F.G) ssd_prompt_unit(F, args, u);
        for (int u = blockIdx.x; u < 1024; u += F.G) ssd_sample_unit(F, args, u);
    } SEAM(2);
    if (IN(3)) {
        pg8::Gemm g{(const pg8::bf16_t*)(ws + WS_G), (const pg8::bf16_t*)(ws + WS_WGLU), MROWS, 2048, 2048}; pg8::StaticOrder S; S.init(MROWS, 2048, F.G, (int)blockIdx.x);
        pg8::EpiGlu E{(const pg8::bf16_t*)(ws + WS_G), args.in[I_BGLU], (pg8::bf16_t*)(ws + WS_MIX)};
        pg8::gemm_phase<pg8::EpiGlu, pg8::StaticOrder, true, true>(F.lds, g, S, E);
        p3_ssd_norm(F, args);
    } SEAM(3);
    if (IN(4)) {
        pg8::Gemm g{(const pg8::bf16_t*)(ws + WS_MIX), (const pg8::bf16_t*)(ws + WS_WOUT), MROWS, DM, DM}; pg8::StaticOrder S; S.init(MROWS, DM, F.G, (int)blockIdx.x);
        pg8::EpiStoreBf16 E{(pg8::bf16_t*)(ws + WS_MIXO), DM};
        pg8::gemm_phase<pg8::EpiStoreBf16, pg8::StaticOrder, true, true>(F.lds, g, S, E);
    } SEAM(4);
    if (IN(5)) { p5_rows(F, args); } SEAM(5);
    if (IN(6)) {
        pg8::Gemm g{(const pg8::bf16_t*)(ws + WS_HN), (const pg8::bf16_t*)(ws + WS_WUP), MROWS, N_UP, DM}; pg8::StaticOrder S; S.init(MROWS, N_UP, F.G, (int)blockIdx.x);
        pg8::EpiUp E{(pg8::bf16_t*)(ws + WS_UP), args.out + O_PFFN, args.out + O_SFFN};
        pg8::gemm_phase<pg8::EpiUp, pg8::StaticOrder, true, true>(F.lds, g, S, E);
    } SEAM(6);
    if (IN(7)) { p7_conv_geglu(F, args); } SEAM(7);
    if (IN(8)) {
        pg8::Gemm g{(const pg8::bf16_t*)(ws + WS_ACT), (const pg8::bf16_t*)(ws + WS_WDN), MROWS, DM, D_FF}; pg8::StaticOrder S; S.init(MROWS, DM, F.G, (int)blockIdx.x);
        pg8::EpiStoreBf16 E{(pg8::bf16_t*)(ws + WS_FF), DM};
        pg8::gemm_phase<pg8::EpiStoreBf16, pg8::StaticOrder, true, true>(F.lds, g, S, E);
    } SEAM(8);
    if (IN(9)) { p9_rows(F, args); }
#undef IN
#undef SEAM
}

extern "C" void kernel_launch(void* const* d_in, const int* in_sizes, int n_in, void* d_out, int out_size, void* d_ws, size_t ws_size, hipStream_t stream) {
    static int grid = 0;
    if (grid == 0) {
        if (n_in != 33 || (size_t)out_size != O_END || ws_size < WS_END) { fprintf(stderr, "kernel_launch: unexpected shapes: n_in %d out %d ws %zu (need %zu); nothing launched\n", n_in, out_size, ws_size, (size_t)WS_END); grid = -1; return; }
        int dev = 0, cus = 0, per_cu = 0;
        if (hipGetDevice(&dev) != hipSuccess || hipDeviceGetAttribute(&cus, hipDeviceAttributeMultiprocessorCount, dev) != hipSuccess) { grid = -1; return; }
        if (hipFuncSetAttribute((const void*)mk_fwd, hipFuncAttributeMaxDynamicSharedMemorySize, LDS_BYTES) != hipSuccess) { fprintf(stderr, "kernel_launch: hipFuncSetAttribute failed\n"); grid = -1; return; }
        if (hipOccupancyMaxActiveBlocksPerMultiprocessor(&per_cu, (const void*)mk_fwd, NWAVES * 64, LDS_BYTES) != hipSuccess || per_cu < 1) { fprintf(stderr, "kernel_launch: occupancy query says %d blocks per CU\n", per_cu); per_cu = 1; }
        (void)hipGetLastError();
        grid = cus;
    }
    if (grid < 0) return;
    if (hipMemsetAsync((char*)d_ws + WS_CTL, 0, CTL_ZERO_BYTES, stream) != hipSuccess) return;
    Args a{};
    for (int i = 0; i < 33; ++i) a.in[i] = (const float*)d_in[i];
    a.out = (float*)d_out; a.ws = (unsigned char*)d_ws;
#if MK_N_LAUNCHES == 1
    a.ph_lo = 0; a.ph_hi = MK_PH_HI;
    hipLaunchKernelGGL(mk_fwd, dim3(grid), dim3(NWAVES * 64), LDS_BYTES, stream, a);
#else
    for (int p = 0; p < MK_PH_HI; ++p) { a.ph_lo = p; a.ph_hi = p + 1; hipLaunchKernelGGL(mk_fwd, dim3(grid), dim3(NWAVES * 64), LDS_BYTES, stream, a); }
#endif
    const hipError_t le = hipPeekAtLastError();
    if (le != hipSuccess) fprintf(stderr, "kernel_launch: launch failed: %s\n", hipGetErrorName(le));
}
```

```cpp
#include <hip/hip_runtime.h>
#include <cstdio>
#include <cstdint>

namespace pg8 {
#define PG8_LAS __attribute__((address_space(3)))
typedef unsigned short bf16_t;
typedef short bf16x8 __attribute__((ext_vector_type(8)));
typedef float f32x4 __attribute__((ext_vector_type(4)));
typedef unsigned u32x4 __attribute__((ext_vector_type(4)));
constexpr int BM = 256, BK = 64, HALF = 128, HTB = HALF * BK * 2  , STAGE_BYTES = 8 * HTB, NXCD = 8, WGM = 8;

__host__ __device__ __forceinline__ int lds_byte(int r, int c) { const int st = (r >> 4) * 2 + (c >> 5), rr = r & 15, cc = c & 31, ob = rr * 64 + cc * 2; return st * 1024 + (ob ^ (((ob >> 9) & 1) << 5)); }
__host__ __device__ __forceinline__ void stage_rc(int b, int& R, int& C) { const int st = b / 1024, sb = b % 1024, swz = sb ^ (((sb >> 9) & 1) << 5); R = (st >> 1) * 16 + swz / 64; C = (st & 1) * 32 + (swz % 64) / 2; }
__host__ __device__ __forceinline__ int perm32(int rho) { const int n = rho >> 4, i = rho & 15; return 8 * (i >> 2) + 4 * n + (i & 3); }

struct Unit { int pm, pn, kk;
    __host__ __device__ __forceinline__ int k0() const { return kk & 1023; }
    __host__ __device__ __forceinline__ int nk() const { return (kk >> 10) & 1023; }
    __host__ __device__ __forceinline__ int part() const { return (kk >> 20) - 1; }
    __host__ __device__ __forceinline__ void set(int k0_, int nk_, int part_) { kk = k0_ | (nk_ << 10) | ((part_ + 1) << 20); } };
struct Gemm { const bf16_t* A; const bf16_t* Bt; int M, N, K; };

struct StaticOrder {
    int nM, nN, nwg, G, c, ntk;
    __host__ __device__ __forceinline__ void init(int M, int N, int G_, int c_, int K_) { nM = M / BM; nN = N / BM; nwg = nM * nN; G = G_; c = c_; ntk = K_ / BK; }
    __host__ __device__ __forceinline__ bool next(int i, Unit& u) const {
        const long L = (long)i * G + c; const bool ok = L < nwg;
        int wgid = ok ? (int)L : 0; { const int q = nwg / NXCD, r = nwg % NXCD, xcd = wgid % NXCD, off = wgid / NXCD; wgid = (xcd < r ? xcd * (q + 1) : r * (q + 1) + (xcd - r) * q) + off; }
        const int nig = WGM * nN, gid = wgid / nig, fm = gid * WGM, gsz = (nM - fm) < WGM ? (nM - fm) : WGM;
        u.pm = fm + ((wgid % nig) % gsz); u.pn = (wgid % nig) / gsz; u.set(0, ntk, -1); return ok;
    }
    __device__ __forceinline__ void a_ready(const Unit&) const {}
    __device__ __forceinline__ void done(const Unit&) const {}
};


struct TailSplitOrder {
    StaticOrder full; int nfull_rounds, tpm, tpn, tkk; bool split;
    __host__ __device__ __forceinline__ void init(int M, int Mfull, int N, int G_, int c_, int K_) {
        const int ntk = K_ / BK, nN = N / BM, pm0 = Mfull / BM, ntail = (M - Mfull) / BM * nN;
        split = (ntail * 4 == G_) && (((Mfull / BM) * nN) % G_ == 0) && (ntk % 8 == 0 || ntk % 8 == 4);
        if (split) { full.init(Mfull, N, G_, c_, K_); nfull_rounds = (Mfull / BM) * nN / G_; } else { full.init(M, N, G_, c_, K_); nfull_rounds = 1 << 30; }
        const int j = c_ >> 2, qd = c_ & 3, base = (ntk / 4) & ~1, extra = (ntk - 4 * base) / 2;
        Unit s; s.set(qd * base + 2 * (qd < extra ? qd : extra), base + (qd < extra ? 2 : 0), qd * ntail + j); tpm = pm0 + j / nN; tpn = j % nN; tkk = s.kk;
    }
    __host__ __device__ __forceinline__ bool next(int i, Unit& u) const {
        const bool isfull = i < nfull_rounds; Unit t; const bool okf = full.next(isfull ? i : 0, t);
        u.pm = isfull ? t.pm : tpm; u.pn = isfull ? t.pn : tpn; u.kk = isfull ? t.kk : tkk;
        return isfull ? okf : (i == nfull_rounds);
    }
    __device__ __forceinline__ void a_ready(const Unit&) const {}
    __device__ __forceinline__ void done(const Unit&) const {}
};

struct SameTileOrder {
    StaticOrder s;
    __host__ __device__ __forceinline__ bool next(int i, Unit& u) const { Unit t; const bool ok = s.next(i, t); u.pm = 0; u.pn = 0; u.kk = t.kk; return ok; }
    __device__ __forceinline__ void a_ready(const Unit&) const {}
    __device__ __forceinline__ void done(const Unit&) const {}
};

__device__ __forceinline__ unsigned cvt_pk_bf16(float lo, float hi) { unsigned r; asm volatile("v_cvt_pk_bf16_f32 %0, %1, %2" : "=v"(r) : "v"(lo), "v"(hi)); return r; }
__device__ __forceinline__ u32x4 pack8(const f32x4 v0, const f32x4 v1) { u32x4 w; w.x = cvt_pk_bf16(v0[0], v0[1]); w.y = cvt_pk_bf16(v0[2], v0[3]); w.z = cvt_pk_bf16(v1[0], v1[1]); w.w = cvt_pk_bf16(v1[2], v1[3]); return w; }
__device__ __forceinline__ float bf_lo(unsigned w) { return __uint_as_float(w << 16); }
__device__ __forceinline__ float bf_hi(unsigned w) { return __uint_as_float(w & 0xffff0000u); }

struct EpiStoreBf16 {
    static constexpr bool PERM = true, AFTER_DRAIN = false;
    bf16_t* O; int ldc;
    __device__ __forceinline__ void operator()(const f32x4 (&acc)[2][2][4][2], const Unit& u, int wr, int wc, int fr, int fq) const {
        const int row0 = u.pm * BM + wr * 64 + fr, col0 = u.pn * BM + wc * 32 + 8 * fq;
#pragma unroll
        for (int ai = 0; ai < 2; ++ai)
#pragma unroll
            for (int m = 0; m < 4; ++m) { bf16_t* rowp = O + (size_t)(row0 + ai * HALF + m * 16) * ldc + col0;
#pragma unroll
                for (int bj = 0; bj < 2; ++bj) *(u32x4*)(rowp + bj * HALF) = pack8(acc[ai][bj][m][0], acc[ai][bj][m][1]); }
    }
};
struct EpiProj {
    static constexpr bool PERM = true, AFTER_DRAIN = false;
    bf16_t* UG; bf16_t* Z; bf16_t* XBC; float* DT; int Mrows;
    __device__ __forceinline__ void operator()(const f32x4 (&acc)[2][2][4][2], const Unit& u, int wr, int wc, int fr, int fq) const {
        const int row0 = u.pm * BM + wr * 64 + fr, cl = wc * 32 + 8 * fq;
        if (u.pn < 8) {
#pragma unroll
            for (int ai = 0; ai < 2; ++ai)
#pragma unroll
                for (int m = 0; m < 4; ++m) { const int row = row0 + ai * HALF + m * 16;
#pragma unroll
                    for (int bj = 0; bj < 2; ++bj) { const int col = u.pn * BM + bj * HALF + cl; const int g = col >> 4, h0 = col & 15;
                        *(u32x4*)(UG + ((size_t)g * Mrows + row) * 16 + h0) = pack8(acc[ai][bj][m][0], acc[ai][bj][m][1]); } }
        } else if (u.pn < 32) {
            bf16_t* base = u.pn < 16 ? Z : XBC; const int ldc = u.pn < 16 ? 2048 : 4096; const int colt = (u.pn < 16 ? (u.pn - 8) : (u.pn - 16)) * BM + cl;
#pragma unroll
            for (int ai = 0; ai < 2; ++ai)
#pragma unroll
                for (int m = 0; m < 4; ++m) { bf16_t* rowp = base + (size_t)(row0 + ai * HALF + m * 16) * ldc + colt;
#pragma unroll
                    for (int bj = 0; bj < 2; ++bj) *(u32x4*)(rowp + bj * HALF) = pack8(acc[ai][bj][m][0], acc[ai][bj][m][1]); }
        } else {
            if (wc == 0) {
#pragma unroll
                for (int ai = 0; ai < 2; ++ai)
#pragma unroll
                    for (int m = 0; m < 4; ++m) { float* rowp = DT + (size_t)(row0 + ai * HALF + m * 16) * 32 + 8 * fq;
                        *(f32x4*)(rowp) = acc[ai][0][m][0]; *(f32x4*)(rowp + 4) = acc[ai][0][m][1]; }
            }
        }
    }
};
struct EpiGlu {
    static constexpr bool PERM = true, AFTER_DRAIN = false;
    const bf16_t* G; const float* bias; bf16_t* MIX;
    __device__ __forceinline__ void operator()(const f32x4 (&acc)[2][2][4][2], const Unit& u, int wr, int wc, int fr, int fq) const {
        const int row0 = u.pm * BM + wr * 64 + fr, col0 = u.pn * BM + wc * 32 + 8 * fq;
        f32x4 bv[2][2];
#pragma unroll
        for (int bj = 0; bj < 2; ++bj)
#pragma unroll
            for (int n = 0; n < 2; ++n) bv[bj][n] = *(const f32x4*)(bias + col0 + bj * HALF + 4 * n);
#pragma unroll
        for (int ai = 0; ai < 2; ++ai)
#pragma unroll
            for (int m = 0; m < 4; ++m) { const size_t row = (size_t)(row0 + ai * HALF + m * 16);
#pragma unroll
                for (int bj = 0; bj < 2; ++bj) { const int col = col0 + bj * HALF;
                    const u32x4 gw = *(const u32x4*)(G + row * 2048 + col);
                    f32x4 v0 = acc[ai][bj][m][0] + bv[bj][0], v1 = acc[ai][bj][m][1] + bv[bj][1];
                    f32x4 g0 = (f32x4){bf_lo(gw.x), bf_hi(gw.x), bf_lo(gw.y), bf_hi(gw.y)}, g1 = (f32x4){bf_lo(gw.z), bf_hi(gw.z), bf_lo(gw.w), bf_hi(gw.w)};
#pragma unroll
                    for (int j = 0; j < 4; ++j) { v0[j] = g0[j] * __builtin_amdgcn_rcpf(1.0f + __expf(-v0[j])); v1[j] = g1[j] * __builtin_amdgcn_rcpf(1.0f + __expf(-v1[j])); }
                    *(u32x4*)(MIX + row * 4096 + col) = pack8(v0, v1); } }
    }
};
struct EpiUp {
    static constexpr bool PERM = true, AFTER_DRAIN = false;
    bf16_t* UP; float* pffn; float* sffn;
    __device__ __forceinline__ void operator()(const f32x4 (&acc)[2][2][4][2], const Unit& u, int wr, int wc, int fr, int fq) const {
        const int row0 = u.pm * BM + wr * 64 + fr, col0 = u.pn * BM + wc * 32 + 8 * fq;
#pragma unroll
        for (int ai = 0; ai < 2; ++ai)
#pragma unroll
            for (int m = 0; m < 4; ++m) { const int row = row0 + ai * HALF + m * 16; bf16_t* rowp = UP + (size_t)row * 22016 + col0;
                float* st = nullptr;
                if (row < 8192) { const int t = row & 2047; if (t >= 2046) st = pffn + (size_t)((row >> 11) * 2 + (t - 2046)) * 22016; }
                else { const int r2 = row - 8192, t = r2 & 7; if (t >= 6) st = sffn + (size_t)((r2 >> 3) * 2 + (t - 6)) * 22016; }
#pragma unroll
                for (int bj = 0; bj < 2; ++bj) { *(u32x4*)(rowp + bj * HALF) = pack8(acc[ai][bj][m][0], acc[ai][bj][m][1]);
                    if (st) { *(f32x4*)(st + col0 + bj * HALF) = acc[ai][bj][m][0]; *(f32x4*)(st + col0 + bj * HALF + 4) = acc[ai][bj][m][1]; } } }
    }
};

template <class Inner> struct EpiSplit {
    static constexpr bool PERM = Inner::PERM, AFTER_DRAIN = false;
    Inner inner; float* PART;
    __device__ __forceinline__ void operator()(const f32x4 (&acc)[2][2][4][2], const Unit& u, int wr, int wc, int fr, int fq) const {
        if (u.part() < 0) { inner(acc, u, wr, wc, fr, fq); return; }
        static_assert(Inner::PERM, "EpiSplit assumes the PERM = true layout");
        bf16_t* base = (bf16_t*)PART + (size_t)u.part() * 65536 + (size_t)(wr * 64 + fr) * 256 + wc * 32 + 8 * fq;
#pragma unroll
        for (int ai = 0; ai < 2; ++ai)
#pragma unroll
            for (int m = 0; m < 4; ++m) { bf16_t* rowp = base + (size_t)(ai * HALF + m * 16) * 256;
#pragma unroll
                for (int bj = 0; bj < 2; ++bj) *(u32x4*)(rowp + bj * HALF) = pack8(acc[ai][bj][m][0], acc[ai][bj][m][1]); }
    }
};
template <class Epi, class Sched, bool ALIGN_EPI = false, bool SP2 = false>
__device__ __forceinline__ void gemm_phase(PG8_LAS unsigned char* lds, const Gemm g, const Sched& S, const Epi& E) {
    const int tid = threadIdx.x, wid = __builtin_amdgcn_readfirstlane(tid >> 6), lane = tid & 63, wr = wid >> 2, wc = wid & 3, fr = lane & 15, fq = lane >> 4;
    const int K = g.K;
    unsigned voffA[2], voffB[2];
#pragma unroll
    for (int i = 0; i < 2; ++i) { int R, C; stage_rc(tid * 16 + i * 8192, R, C); const int Rb = Epi::PERM ? ((R & ~31) + perm32(R & 31)) : R;
        voffA[i] = (unsigned)(R * K + C) * 2u; voffB[i] = (unsigned)(Rb * K + C) * 2u; }
    const size_t kstep = (size_t)(BK * 2);
    const size_t hstep = (size_t)HALF * K * 2;
    const size_t tstep = 2 * hstep;
    const unsigned ldsw = (unsigned)wid * 1024u;
    const int aoff = lds_byte(wr * 64 + fr, fq * 8), boff = lds_byte(wc * 32 + fr, fq * 8);
#define PG8_SA(b, h) (((b) * 2 + (h)) * HTB)
#define PG8_SB(b, h) ((4 + (b) * 2 + (h)) * HTB)
#define PG8_STAGE(bufoff, gbase, voff) do { _Pragma("unroll") for (int _i = 0; _i < 2; ++_i) \
        __builtin_amdgcn_global_load_lds((const unsigned*)((const char*)(gbase) + (voff)[_i]), (PG8_LAS unsigned*)(lds + (bufoff) + ldsw + _i * 8192), 16, 0, 0); } while (0)
#define PG8_LDA(dst, b, h) do { _Pragma("unroll") for (int m = 0; m < 4; ++m) _Pragma("unroll") for (int k = 0; k < 2; ++k) dst[m][k] = *(const PG8_LAS bf16x8*)(lds + PG8_SA(b, h) + aoff + m * 2048 + k * 1024); } while (0)
#define PG8_LDB(dst, b, h) do { _Pragma("unroll") for (int n = 0; n < 2; ++n) _Pragma("unroll") for (int k = 0; k < 2; ++k) dst[n][k] = *(const PG8_LAS bf16x8*)(lds + PG8_SB(b, h) + boff + n * 2048 + k * 1024); } while (0)
#define PG8_MMA(ai, bj, At, Bt) do { __builtin_amdgcn_s_setprio(1); _Pragma("unroll") for (int m = 0; m < 4; ++m) _Pragma("unroll") for (int n = 0; n < 2; ++n) _Pragma("unroll") for (int k = 0; k < 2; ++k) \
        acc[ai][bj][m][n] = __builtin_amdgcn_mfma_f32_16x16x32_bf16(Bt[n][k], At[m][k], acc[ai][bj][m][n], 0, 0, 0); __builtin_amdgcn_s_setprio(0); } while (0)
#define PG8_WAIT_V(n) asm volatile("s_waitcnt vmcnt(" #n ")" ::: "memory")
#define PG8_WAIT_L(n) asm volatile("s_waitcnt lgkmcnt(" #n ")" ::: "memory")
#define PG8_BAR __builtin_amdgcn_s_barrier()
#define PG8_SCHED __builtin_amdgcn_sched_barrier(0)
    Unit cur, nxt; int ui = 0;
    if (!S.next(0, cur)) return;
    f32x4 acc[2][2][4][2];
#pragma unroll
    for (int a = 0; a < 2; ++a)
#pragma unroll
        for (int b = 0; b < 2; ++b)
#pragma unroll
            for (int m = 0; m < 4; ++m)
#pragma unroll
                for (int n = 0; n < 2; ++n) acc[a][b][m][n] = (f32x4){0.f, 0.f, 0.f, 0.f};
    bf16x8 At[4][2], B0[2][2], B1[2][2];
    const char* cA = (const char*)g.A + (size_t)cur.pm * tstep + (size_t)cur.k0() * kstep; const char* cB = (const char*)g.Bt + (size_t)cur.pn * tstep + (size_t)cur.k0() * kstep;
    int nt = cur.nk();
    S.a_ready(cur);
    if constexpr (SP2) {
        PG8_STAGE(PG8_SB(0, 0), cB, voffB); PG8_STAGE(PG8_SB(0, 1), cB + hstep, voffB); PG8_STAGE(PG8_SA(0, 0), cA, voffA); PG8_STAGE(PG8_SA(0, 1), cA + hstep, voffA);
        if (wr == 1) PG8_BAR;
        PG8_WAIT_V(2); PG8_BAR;
        PG8_STAGE(PG8_SB(1, 0), cB + kstep, voffB); PG8_STAGE(PG8_SA(1, 0), cA + kstep, voffA); PG8_STAGE(PG8_SB(1, 1), cB + hstep + kstep, voffB);
        PG8_WAIT_V(6); PG8_BAR;
    } else {
        PG8_STAGE(PG8_SB(0, 0), cB, voffB); PG8_STAGE(PG8_SA(0, 0), cA, voffA); PG8_STAGE(PG8_SB(0, 1), cB + hstep, voffB); PG8_STAGE(PG8_SA(0, 1), cA + hstep, voffA);
        if (wr == 1) PG8_BAR;
        PG8_WAIT_V(4); PG8_BAR;
        PG8_STAGE(PG8_SB(1, 0), cB + kstep, voffB); PG8_STAGE(PG8_SA(1, 0), cA + kstep, voffA); PG8_STAGE(PG8_SB(1, 1), cB + hstep + kstep, voffB);
        PG8_WAIT_V(6); PG8_BAR;
    }
    for (;;) {
        const bool has_next = S.next(ui + 1, nxt);
        const char* nA = has_next ? (const char*)g.A + (size_t)nxt.pm * tstep + (size_t)nxt.k0() * kstep : cA; const char* nB = has_next ? (const char*)g.Bt + (size_t)nxt.pn * tstep + (size_t)nxt.k0() * kstep : cB;
        for (int t = 0; t < nt; t += 2) {
            const bool last = (t == nt - 2);
            const char* a1 = cA + (size_t)(t + 1) * kstep;
            const char* a2 = last ? nA : cA + (size_t)(t + 2) * kstep; const char* b2 = last ? nB : cB + (size_t)(t + 2) * kstep;
            const char* a3 = a2 + kstep; const char* b3 = b2 + kstep;
            if (last && has_next) S.a_ready(nxt);
            if constexpr (SP2) {
            PG8_LDB(B0, 0, 0); PG8_LDB(B1, 0, 1); PG8_SCHED; PG8_LDA(At, 0, 0); PG8_STAGE(PG8_SA(1, 1), a1 + hstep, voffA);
            PG8_WAIT_V(8); PG8_WAIT_L(0); PG8_BAR; PG8_MMA(0, 0, At, B0); PG8_MMA(0, 1, At, B1); PG8_BAR; PG8_SCHED;
            PG8_LDA(At, 0, 1); PG8_STAGE(PG8_SB(0, 0), b2, voffB); PG8_STAGE(PG8_SB(0, 1), b2 + hstep, voffB); PG8_STAGE(PG8_SA(0, 0), a2, voffA);
            PG8_WAIT_V(8); PG8_WAIT_L(0); PG8_BAR; PG8_MMA(1, 0, At, B0); PG8_MMA(1, 1, At, B1); PG8_BAR; PG8_SCHED;
            PG8_LDB(B0, 1, 0); PG8_LDB(B1, 1, 1); PG8_SCHED; PG8_LDA(At, 1, 0); PG8_STAGE(PG8_SA(0, 1), a2 + hstep, voffA);
            PG8_WAIT_V(8); PG8_WAIT_L(0); PG8_BAR; PG8_MMA(0, 0, At, B0); PG8_MMA(0, 1, At, B1); PG8_BAR; PG8_SCHED;
            PG8_LDA(At, 1, 1); PG8_STAGE(PG8_SB(1, 0), b3, voffB); PG8_STAGE(PG8_SB(1, 1), b3 + hstep, voffB); PG8_STAGE(PG8_SA(1, 0), a3, voffA);
            PG8_WAIT_V(8); PG8_WAIT_L(0); PG8_BAR; PG8_MMA(1, 0, At, B0); PG8_MMA(1, 1, At, B1); PG8_BAR; PG8_SCHED;
            } else {
            PG8_LDB(B0, 0, 0); PG8_SCHED; PG8_LDA(At, 0, 0); PG8_STAGE(PG8_SA(1, 1), a1 + hstep, voffA);
            PG8_WAIT_L(8); PG8_BAR; PG8_WAIT_L(0); PG8_MMA(0, 0, At, B0); PG8_BAR; PG8_SCHED;
            PG8_LDB(B1, 0, 1); PG8_STAGE(PG8_SB(0, 0), b2, voffB);
            PG8_BAR; PG8_WAIT_L(0); PG8_MMA(0, 1, At, B1); PG8_BAR;
            PG8_LDA(At, 0, 1); PG8_STAGE(PG8_SA(0, 0), a2, voffA);
            PG8_BAR; PG8_WAIT_L(0); PG8_MMA(1, 0, At, B0); PG8_BAR; PG8_SCHED;
            PG8_STAGE(PG8_SB(0, 1), b2 + hstep, voffB);
            PG8_WAIT_V(6); PG8_BAR; PG8_MMA(1, 1, At, B1); PG8_BAR;
            PG8_LDB(B0, 1, 0); PG8_SCHED; PG8_LDA(At, 1, 0); PG8_STAGE(PG8_SA(0, 1), a2 + hstep, voffA);
            PG8_WAIT_L(8); PG8_BAR; PG8_WAIT_L(0); PG8_MMA(0, 0, At, B0); PG8_BAR; PG8_SCHED;
            PG8_LDB(B1, 1, 1); PG8_STAGE(PG8_SB(1, 0), b3, voffB);
            PG8_BAR; PG8_WAIT_L(0); PG8_MMA(0, 1, At, B1); PG8_BAR;
            PG8_LDA(At, 1, 1); PG8_STAGE(PG8_SA(1, 0), a3, voffA);
            PG8_BAR; PG8_WAIT_L(0); PG8_MMA(1, 0, At, B0); PG8_BAR; PG8_SCHED;
            PG8_STAGE(PG8_SB(1, 1), b3 + hstep, voffB);
            PG8_WAIT_V(6); PG8_BAR; PG8_MMA(1, 1, At, B1); PG8_BAR;
            }
        }
        if constexpr (ALIGN_EPI) { if (wr == 0) PG8_BAR; }
        if constexpr (!Epi::AFTER_DRAIN) { E(acc, cur, wr, wc, fr, fq); S.done(cur); }
        if (!has_next) break;
#pragma unroll
        for (int a = 0; a < 2; ++a)
#pragma unroll
            for (int b = 0; b < 2; ++b)
#pragma unroll
                for (int m = 0; m < 4; ++m)
#pragma unroll
                    for (int n = 0; n < 2; ++n) acc[a][b][m][n] = (f32x4){0.f, 0.f, 0.f, 0.f};
        cur = nxt; cA = nA; cB = nB; ++ui; nt = cur.nk();
        if constexpr (ALIGN_EPI) { if (wr == 1) PG8_BAR; }
    }
    PG8_WAIT_V(0);
    if constexpr (!ALIGN_EPI) { if (wr == 0) PG8_BAR; }
    PG8_BAR;
    if constexpr (Epi::AFTER_DRAIN) { E.fused(acc, cur, wr, wc, fr, fq, lds, wid, lane); S.done(cur); }
#undef PG8_SA
#undef PG8_SB
#undef PG8_STAGE
#undef PG8_LDA
#undef PG8_LDB
#undef PG8_MMA
#undef PG8_WAIT_V
#undef PG8_WAIT_L
#undef PG8_BAR
#undef PG8_SCHED
}
}
#define GAS __attribute__((address_space(1)))
#define LAS __attribute__((address_space(3)))
typedef unsigned short bf16;
typedef unsigned v4u __attribute__((ext_vector_type(4)));
typedef float f32x4 __attribute__((ext_vector_type(4)));
typedef short bf16x8 __attribute__((ext_vector_type(8)));
typedef GAS unsigned gu32;
typedef GAS unsigned long long gu64;
#define RLX_AGENT __ATOMIC_RELAXED, __HIP_MEMORY_SCOPE_AGENT
#define LDS_WAIT() asm volatile("s_waitcnt lgkmcnt(0)" ::: "memory")
#define VM_WAIT() asm volatile("s_waitcnt vmcnt(0)" ::: "memory")
__device__ __forceinline__ unsigned long long rt() { return __builtin_amdgcn_s_memrealtime(); }
__device__ __forceinline__ unsigned f2bf(float f) { unsigned u = __builtin_bit_cast(unsigned, f); return (u + 0x7fffu + ((u >> 16) & 1u)) >> 16; }
typedef float f32x2_t __attribute__((ext_vector_type(2)));
typedef __bf16 bf16x2_t __attribute__((ext_vector_type(2)));
__device__ __forceinline__ unsigned pk2(float lo, float hi) { const f32x2_t v = {lo, hi}; return __builtin_bit_cast(unsigned, __builtin_convertvector(v, bf16x2_t)); }

#define XB_TMO      128
#define XB_XCNT(j)  (256  + 64 * (j))
#define XB_XSUB(j)  (1280 + 64 * (j))
#define XB_XGEN(j)  (2304 + 64 * (j))
#define XB_TOP      3328
#define XB_TOPGEN   3392
#define XCD_BAR_WORDS 3456
#define XB_SPIN_CAP (1u << 18)

__device__ __forceinline__ unsigned xb_ld(unsigned* p)              { return __hip_atomic_load(p, __ATOMIC_RELAXED, __HIP_MEMORY_SCOPE_AGENT); }
__device__ __forceinline__ unsigned xb_add(unsigned* p, unsigned v) { return __hip_atomic_fetch_add(p, v, __ATOMIC_RELAXED, __HIP_MEMORY_SCOPE_AGENT); }
__device__ __forceinline__ unsigned xb_xcc_id() { return (unsigned)__builtin_amdgcn_s_getreg((3 << 11) | 20) & 0xFu; }
#define XB_SPIN(cond, bar) do { unsigned _sp = 0; while (cond) { __builtin_amdgcn_s_sleep(1); \
    if ((++_sp & 255u) == 0u) { if (xb_ld(&(bar)[XB_TMO])) break; if (_sp > XB_SPIN_CAP) { atomicAdd(&(bar)[XB_TMO], 1u); break; } } } } while (0)

struct XcdBarrier {
    unsigned* bar; unsigned x;
    volatile LAS unsigned* st;
};

__device__ __forceinline__ XcdBarrier xcd_barrier_post(unsigned* bar, volatile LAS unsigned* st) {
    XcdBarrier b; b.bar = bar; b.x = xb_xcc_id(); b.st = st;
    if (threadIdx.x == 0) (void)xb_add(&bar[XB_XCNT(b.x)], 1u);
    return b;
}
__device__ __forceinline__ void xcd_barrier_complete(unsigned* bar, unsigned x, unsigned& nloc, unsigned& nx) {
    const unsigned G = gridDim.x * gridDim.y * gridDim.z;
    unsigned sum, cnt, mine, sp = 0u;
    for (;;) {
        sum = 0u; cnt = 0u; mine = 0u;
#pragma unroll
        for (unsigned j = 0; j < 16; ++j) { const unsigned c = xb_ld(&bar[XB_XCNT(j)]); sum += c; cnt += (c > 0u) ? 1u : 0u; mine = (j == x) ? c : mine; }
        if (sum == G) break;
        __builtin_amdgcn_s_sleep(1);
        if ((++sp & 255u) == 0u) { if (xb_ld(&bar[XB_TMO])) break; if (sp > XB_SPIN_CAP) { atomicAdd(&bar[XB_TMO], 1u); break; } }
    }
    nloc = mine > 0u ? mine : 1u; nx = cnt > 0u ? cnt : 1u;
}

__device__ __forceinline__ void xcd_barrier(const XcdBarrier& b) {
    asm volatile("s_waitcnt vmcnt(0)" ::: "memory");
    __syncthreads();
    if (threadIdx.x == 0) {
        unsigned* bar = b.bar;
        __builtin_amdgcn_s_waitcnt(0);
        unsigned nloc = b.st[0], nx = b.st[1];
        if (nloc == 0u) { xcd_barrier_complete(bar, b.x, nloc, nx); b.st[0] = nloc; b.st[1] = nx; }
        const unsigned old = xb_add(&bar[XB_XSUB(b.x)], 1u);
        const unsigned gen = old / nloc;
        if (old + 1u == (gen + 1u) * nloc) {
            __builtin_amdgcn_fence(__ATOMIC_RELEASE, "agent");
            asm volatile("s_waitcnt vmcnt(0)" ::: "memory");
            const unsigned og = xb_add(&bar[XB_TOP], 1u);
            const unsigned tg = og / nx;
            if (og + 1u == (tg + 1u) * nx) xb_add(&bar[XB_TOPGEN], 1u);
            else XB_SPIN(xb_ld(&bar[XB_TOPGEN]) == tg, bar);
            __builtin_amdgcn_fence(__ATOMIC_ACQUIRE, "agent");
            xb_add(&bar[XB_XGEN(b.x)], 1u);
            asm volatile("s_waitcnt vmcnt(0)" ::: "memory");
        } else {
            XB_SPIN(xb_ld(&bar[XB_XGEN(b.x)]) == gen, bar);
            __builtin_amdgcn_fence(__ATOMIC_ACQUIRE, "agent");
            asm volatile("s_waitcnt vmcnt(0)" ::: "memory");
        }
    }
    __syncthreads();
}

constexpr int NWAVES = 8;
constexpr int DM = 4096, MP = 8192, MS = 1024, MROWS = 9216;
constexpr int D_IN = 8224, N1PAD = 8448, D_FF = 11008, N_UP = 22016;
constexpr float EPS = 1e-6f;
#ifndef MK_PH_HI
#define MK_PH_HI 10
#endif
#ifndef MK_N_LAUNCHES
#define MK_N_LAUNCHES 1
#endif
constexpr int N_PHASES = 10;

constexpr size_t O_Y = 0;
constexpr size_t O_PS5RE = (size_t)MROWS * DM;
constexpr size_t O_PS5IM = O_PS5RE + 4 * 128 * 64;
constexpr size_t O_PCONV = O_PS5IM + 4 * 128 * 64;
constexpr size_t O_PSSD  = O_PCONV + 4 * 3 * 4096;
constexpr size_t O_PFFN  = O_PSSD + (size_t)4 * 32 * 64 * 128;
constexpr size_t O_SS5RE = O_PFFN + 4 * 2 * 22016;
constexpr size_t O_SS5IM = O_SS5RE + 128 * 128 * 64;
constexpr size_t O_SCONV = O_SS5IM + 128 * 128 * 64;
constexpr size_t O_SSSD  = O_SCONV + 128 * 3 * 4096;
constexpr size_t O_SFFN  = O_SSSD + (size_t)128 * 32 * 64 * 128;
constexpr size_t O_END   = O_SFFN + (size_t)128 * 2 * 22016;
static_assert(O_END == 81948672, "output size");
constexpr size_t MiB = 1u << 20;
constexpr size_t WS_CTL = 0, CTL_ZERO_BYTES = 1 * MiB;
constexpr size_t WS_LAM = 1 * MiB;
constexpr size_t WS_BBR = 2 * MiB, WS_BBI = 2 * MiB + 512 * 1024;
constexpr size_t WS_KJ  = 3 * MiB;
constexpr size_t WS_DT  = 4 * MiB;
constexpr size_t WS_SSQP = 6 * MiB;
constexpr size_t WS_DTP = 8 * MiB;
constexpr size_t WS_WUP = 24 * MiB;
constexpr size_t WS_WDN = 196 * MiB;
constexpr size_t WS_HN  = 282 * MiB;
constexpr size_t WS_MIXO = 354 * MiB;
constexpr size_t WS_FF  = 426 * MiB;
constexpr size_t WS_ACT = 498 * MiB;
constexpr size_t WS_WIN = 692 * MiB;
constexpr size_t WS_WGLU = 758 * MiB;
constexpr size_t WS_WOUT = 766 * MiB;
constexpr size_t WS_UG  = 798 * MiB;
constexpr size_t WS_Z   = 834 * MiB;
constexpr size_t WS_XBC = 870 * MiB;
constexpr size_t WS_G   = 942 * MiB;
constexpr size_t WS_MIX = 978 * MiB;
constexpr size_t WS_YG  = 1050 * MiB;
constexpr size_t WS_XC  = 1082 * MiB;
constexpr size_t WS_UP  = 692 * MiB;
constexpr size_t WS_PART = 1162 * MiB;
constexpr size_t WS_X1  = 1226 * MiB;
constexpr size_t WS_END = 1298 * MiB;
static_assert(WS_UP + (size_t)MROWS * N_UP * 2 <= WS_XC && WS_ACT + (size_t)MROWS * D_FF * 2 <= WS_WIN, "ws map");
constexpr int CW_BAR = 4096;
constexpr int RING_BYTES = 131072, LDS_BYTES = 147456, MISC_OFF = LDS_BYTES - 256;

struct Frame {
    LAS unsigned char* lds;
    int tid, lane, wave, vcu, G;
};
struct Args { const float* in[33]; float* out; unsigned char* ws; int ph_lo, ph_hi, bli, pad; };
enum { I_XP = 0, I_XS, I_S5RE, I_S5IM, I_SCONV, I_SSSD, I_SFFN, I_GPRE, I_GPOST, I_GFPRE, I_GFPOST, I_WIN, I_ARE, I_AIM, I_LOGDT, I_BRE, I_BIM, I_CRE, I_CIM, I_S5D, I_WGLU, I_BGLU,
       I_CONVW, I_CONVB, I_DTB, I_ALOG, I_SSDD, I_NORMW, I_WOUT, I_WUP, I_FCW, I_FCB, I_WDN };

__device__ __forceinline__ float wave_sum(float v) {
#pragma unroll
    for (int o = 1; o < 64; o <<= 1) v += __shfl_xor(v, o);
    return v;
}
typedef unsigned v2u __attribute__((ext_vector_type(2)));
__device__ __forceinline__ bf16 f2bf1(float x) { return (bf16)pk2(x, x); }
__device__ __forceinline__ float bf2f(bf16 b) { return __uint_as_float(((unsigned)b) << 16); }
__device__ __forceinline__ void unpack8(const v4u w, float (&o)[8]) {
    o[0] = __uint_as_float(w.x << 16); o[1] = __uint_as_float(w.x & 0xffff0000u); o[2] = __uint_as_float(w.y << 16); o[3] = __uint_as_float(w.y & 0xffff0000u);
    o[4] = __uint_as_float(w.z << 16); o[5] = __uint_as_float(w.z & 0xffff0000u); o[6] = __uint_as_float(w.w << 16); o[7] = __uint_as_float(w.w & 0xffff0000u);
}
__device__ __forceinline__ v4u pack8f(const float (&o)[8]) { v4u w; w.x = pk2(o[0], o[1]); w.y = pk2(o[2], o[3]); w.z = pk2(o[4], o[5]); w.w = pk2(o[6], o[7]); return w; }
__device__ __forceinline__ float silu_f(float v) { return v * __builtin_amdgcn_rcpf(1.0f + __expf(-v)); }
__device__ __forceinline__ float gelu_tanh_f(float v) { const float t = 1.5957691216057308f * (v + 0.044715f * v * v * v); return v * __builtin_amdgcn_rcpf(1.0f + __expf(-t)); }
__device__ __forceinline__ float softplus_f(float v) { const float e = __expf(v); return v > 15.f ? v : (v < -4.f ? e * (1.0f - 0.5f * e + 0.33333334f * e * e) : __logf(1.0f + e)); }
typedef unsigned short u16x4_t __attribute__((ext_vector_type(4)));
__device__ __forceinline__ u16x4_t tr_read(unsigned lds_addr) { u16x4_t r; asm volatile("ds_read_b64_tr_b16 %0, %1\n\ts_waitcnt lgkmcnt(0)" : "=&v"(r) : "v"(lds_addr) : "memory"); return r; }
__device__ __forceinline__ bf16x8 tr_frag(unsigned img_base, int pitch, int r0, int c0, int lane) {
    const int g = lane >> 4, qq = (lane & 15) >> 2, pp = lane & 3;
    const unsigned a0 = img_base + (unsigned)(((r0 + 8 * g + qq) * pitch + c0 + 4 * pp) * 2);
    const u16x4_t lo = tr_read(a0), hi = tr_read(a0 + (unsigned)(4 * pitch * 2));
    typedef unsigned short u16x8_t __attribute__((ext_vector_type(8)));
    const u16x8_t v = {lo[0], lo[1], lo[2], lo[3], hi[0], hi[1], hi[2], hi[3]};
    return __builtin_bit_cast(bf16x8, v);
}
__device__ __forceinline__ f32x4 mfma16(bf16x8 a, bf16x8 b, f32x4 c) { return __builtin_amdgcn_mfma_f32_16x16x32_bf16(a, b, c, 0, 0, 0); }

__device__ __forceinline__ void p0_transpose_item(const float* W, int K, int N, bf16* WT, LAS float* scr, int item, int lane) {
    const int nblk = N / 32, kb = item / nblk, nb = item % nblk, k0 = 64 * kb, n0 = 32 * nb;
#pragma unroll 8
    for (int i = 0; i < 32; ++i) { const int kk = 2 * i + (lane >> 5); scr[kk * 33 + (lane & 31)] = W[(size_t)(k0 + kk) * N + n0 + (lane & 31)]; }
    LDS_WAIT(); asm volatile("" ::: "memory");
    const int c = lane & 7;
#pragma unroll
    for (int j = 0; j < 4; ++j) { const int n = (lane >> 3) + 8 * j; const LAS float* s = scr + (8 * c) * 33 + n;
        v4u o; o.x = pk2(s[0 * 33], s[1 * 33]); o.y = pk2(s[2 * 33], s[3 * 33]); o.z = pk2(s[4 * 33], s[5 * 33]); o.w = pk2(s[6 * 33], s[7 * 33]);
        *(GAS v4u*)(WT + (size_t)(n0 + n) * K + k0 + 8 * c) = o; }
    LDS_WAIT(); asm volatile("" ::: "memory");
}
__device__ __forceinline__ void gain_to_lds(LAS unsigned char* lds, int off, const float* g, int tid) {
#pragma unroll
    for (int i = 0; i < 2; ++i) *(LAS f32x4*)(lds + off + (tid + 512 * i) * 16) = ((const f32x4*)g)[tid + 512 * i];
}
__device__ __forceinline__ void rms_row_to_bf16(const float* xrow, const LAS float* gain, bf16* orow, int lane) {
    const f32x4* xr = (const f32x4*)xrow + lane; const LAS f32x4* gr = (const LAS f32x4*)gain + lane;
    f32x4 v[16]; float s = 0.f;
#pragma unroll
    for (int j = 0; j < 16; ++j) { v[j] = xr[64 * j]; s += (v[j].x * v[j].x + v[j].y * v[j].y) + (v[j].z * v[j].z + v[j].w * v[j].w); }
    const float rstd = 1.0f / sqrtf(wave_sum(s) * (1.f / DM) + EPS);
    unsigned long long* o8 = (unsigned long long*)orow + lane;
#pragma unroll
    for (int j = 0; j < 16; ++j) { const f32x4 g = gr[64 * j]; o8[64 * j] = (unsigned long long)pk2(v[j].x * rstd * g.x, v[j].y * rstd * g.y) | ((unsigned long long)pk2(v[j].z * rstd * g.z, v[j].w * rstd * g.w) << 32); }
}
constexpr int CV_IN = (DM / 64) * (D_IN / 32), CV_GL = (2048 / 64) * (2048 / 32), CV_OUT = (DM / 64) * (DM / 32), CV_UP = (DM / 64) * (N_UP / 32), CV_DN = (D_FF / 64) * (DM / 32);
constexpr int CV_UP_P1 = 8192, CV_UP_TAIL = 14336;
__device__ __forceinline__ void convert_stream(const float* W, int K, int N, bf16* WT, LAS float* scr, int lo, int hi, int worker, int nworkers, int lane) {
    const int nblk = N / 32, c = lane & 7;
    f32x4 va[8], vb[8];
#define CV_LOAD(v, item) do { const int kb_ = (item) / nblk, nb_ = (item) % nblk; const float* p_ = W + (size_t)(64 * kb_ + (lane >> 3)) * N + 32 * nb_ + 4 * (lane & 7); \
        _Pragma("unroll") for (int i = 0; i < 8; ++i) v[i] = __builtin_nontemporal_load((const f32x4*)(p_ + (size_t)(8 * i) * N)); } while (0)
#define CV_FINISH(v, item) do { const int kb_ = (item) / nblk, nb_ = (item) % nblk; \
        _Pragma("unroll") for (int i = 0; i < 8; ++i) { LAS float* w_ = scr + (8 * i + (lane >> 3)) * 33 + 4 * (lane & 7); w_[0] = v[i].x; w_[1] = v[i].y; w_[2] = v[i].z; w_[3] = v[i].w; } \
        LDS_WAIT(); asm volatile("" ::: "memory"); \
        _Pragma("unroll") for (int j = 0; j < 4; ++j) { const int n_ = (lane >> 3) + 8 * j; const LAS float* s = scr + (8 * c) * 33 + n_; \
            v4u o; o.x = pk2(s[0 * 33], s[1 * 33]); o.y = pk2(s[2 * 33], s[3 * 33]); o.z = pk2(s[4 * 33], s[5 * 33]); o.w = pk2(s[6 * 33], s[7 * 33]); \
            __builtin_nontemporal_store(o, (GAS v4u*)(WT + (size_t)(32 * nb_ + n_) * K + 64 * kb_ + 8 * c)); } \
        LDS_WAIT(); asm volatile("" ::: "memory"); } while (0)
    int it = lo + worker;
    if (it >= hi) return;
    CV_LOAD(va, it);
    for (;;) {
        const int itn = it + nworkers, itc = itn < hi ? itn : it;
        CV_LOAD(vb, itc);
        CV_FINISH(va, it);
        if (itn >= hi) break;
        const int itn2 = itn + nworkers, itc2 = itn2 < hi ? itn2 : itn;
        CV_LOAD(va, itc2);
        CV_FINISH(vb, itn);
        if (itn2 >= hi) break;
        it = itn2;
    }
#undef CV_LOAD
#undef CV_FINISH
}
__device__ __forceinline__ void convert_items(Frame& F, const Args& a, int which, int lo, int hi, int worker, int nworkers) {
    unsigned char* ws = a.ws; LAS float* scr = (LAS float*)(F.lds + F.wave * 16384);
    const float* W; int K, N; bf16* WT;
    if (which == 0) { W = a.in[I_WIN]; K = DM; N = D_IN; WT = (bf16*)(ws + WS_WIN); }
    else if (which == 1) { W = a.in[I_WGLU]; K = 2048; N = 2048; WT = (bf16*)(ws + WS_WGLU); }
    else if (which == 2) { W = a.in[I_WOUT]; K = DM; N = DM; WT = (bf16*)(ws + WS_WOUT); }
    else if (which == 3) { W = a.in[I_WUP]; K = DM; N = N_UP; WT = (bf16*)(ws + WS_WUP); }
    else { W = a.in[I_WDN]; K = D_FF; N = DM; WT = (bf16*)(ws + WS_WDN); }
    convert_stream(W, K, N, WT, scr, lo, hi, worker, nworkers, F.lane);
}
__device__ __forceinline__ void convert_fill(Frame& F, const Args& a, int nunits, int which, int lo, int hi) {
    if (F.G != 256 || (a.pad & 32)) return;
    const int nbusy = nunits % F.G; if (nbusy == 0 || (int)blockIdx.x < nbusy) return;
    convert_items(F, a, which, lo, hi, ((int)blockIdx.x - nbusy) * NWAVES + F.wave, (F.G - nbusy) * NWAVES);
}
__device__ __forceinline__ void p0_prologue(Frame& F, const Args& a) {
    unsigned char* ws = a.ws;
    LAS float* scr = (LAS float*)(F.lds + F.wave * 16384);
    const int gw = F.vcu * NWAVES + F.wave, NGW = F.G * NWAVES;
    {
        float2* LAM = (float2*)(ws + WS_LAM); float* BBR = (float*)(ws + WS_BBR); float* BBI = (float*)(ws + WS_BBI);
        for (int it = (NGW - 1 - gw) * 64 + F.lane; it < 128 * 64 * 4; it += NGW * 64) {
            const int i = it >> 2, hq = it & 3, g = i >> 6, p = i & 63;
            const float ar = a.in[I_ARE][i], ai = a.in[I_AIM][i], dt = expf(a.in[I_LOGDT][g]);
            const f32x4 br = *(const f32x4*)(a.in[I_BRE] + i * 16 + 4 * hq), bi = *(const f32x4*)(a.in[I_BIM] + i * 16 + 4 * hq);
            const float mag = expf(ar * dt), th = ai * dt;
            const float lbr = mag * cosf(th), lbi = mag * sinf(th);
            if (hq == 0) { float cr = 1.f, ci = 0.f;
#pragma unroll
                for (int j = 0; j < 9; ++j) { LAM[(g * 9 + j) * 64 + p] = make_float2(cr, ci); const float nr = cr * lbr - ci * lbi, ni = cr * lbi + ci * lbr; cr = nr; ci = ni; } }
            const float den = ar * ar + ai * ai, nr1 = lbr - 1.0f;
            const float fr = (nr1 * ar + lbi * ai) / den, fi = (lbi * ar - nr1 * ai) / den;
            *(f32x4*)(BBR + i * 16 + 4 * hq) = fr * br - fi * bi; *(f32x4*)(BBI + i * 16 + 4 * hq) = fr * bi + fi * br;
        }
    }
    const bool spread = (F.G == 256);
    if (!(a.pad & 64)) convert_items(F, a, 0, 0, CV_IN, gw, NGW);
    if (a.pad & 64) {}
    else if (spread) convert_items(F, a, 3, CV_UP_P1 + CV_UP_TAIL, CV_UP, gw, NGW);
    else { convert_items(F, a, 1, 0, CV_GL, gw, NGW); convert_items(F, a, 2, 0, CV_OUT, gw, NGW); convert_items(F, a, 3, 0, CV_UP, gw, NGW); convert_items(F, a, 4, 0, CV_DN, gw, NGW); }
    {
        v4u* z = (v4u*)(ws + WS_WIN + (size_t)D_IN * DM * 2); const int nz = (N1PAD - D_IN) * DM * 2 / 16;
        for (int i = gw * 64 + F.lane; i < nz; i += NGW * 64) z[i] = (v4u){0u, 0u, 0u, 0u};
    }
    __syncthreads();
    gain_to_lds(F.lds, 0, a.in[I_GPRE], F.tid);
    __syncthreads();
    if (!(a.pad & 128)) for (int m = gw; m < MROWS; m += NGW) {
        const float* xrow = m < MP ? a.in[I_XP] + (size_t)m * DM : a.in[I_XS] + (size_t)(m - MP) * DM;
        rms_row_to_bf16(xrow, (const LAS float*)F.lds, (bf16*)(ws + WS_HN) + (size_t)m * DM, F.lane);
    }
}
__device__ __forceinline__ void p1_kj(Frame& F, const Args& a, int gwk, int ngwk) {
    unsigned char* ws = a.ws;
    const float2* LAM = (const float2*)(ws + WS_LAM); const float* BBR = (const float*)(ws + WS_BBR); const float* BBI = (const float*)(ws + WS_BBI); float* KJ = (float*)(ws + WS_KJ);
    const int gt = gwk * 64 + F.lane, NT = ngwk * 64;
    for (int i = gt; i < 128 * 8 * 16 * 4; i += NT) {
        const int g = i >> 9, j = (i >> 6) & 7, h = (i >> 2) & 15, hp0 = 4 * (i & 3);
        f32x4 acc = (f32x4){0.f, 0.f, 0.f, 0.f};
        const f32x4* Lp = (const f32x4*)(LAM + (g * 9 + j) * 64); const f32x4* Cr = (const f32x4*)(a.in[I_CRE] + (g * 16 + h) * 64); const f32x4* Ci = (const f32x4*)(a.in[I_CIM] + (g * 16 + h) * 64);
#pragma unroll 2
        for (int p4 = 0; p4 < 16; ++p4) {
            const f32x4 l0 = Lp[2 * p4], l1 = Lp[2 * p4 + 1], cr = Cr[p4], ci = Ci[p4];
            const float lr[4] = {l0.x, l0.z, l1.x, l1.z}, li[4] = {l0.y, l0.w, l1.y, l1.w}, crv[4] = {cr.x, cr.y, cr.z, cr.w}, civ[4] = {ci.x, ci.y, ci.z, ci.w};
#pragma unroll
            for (int e = 0; e < 4; ++e) { const int p = 4 * p4 + e;
                const f32x4 br = *(const f32x4*)(BBR + (g * 64 + p) * 16 + hp0), bi = *(const f32x4*)(BBI + (g * 64 + p) * 16 + hp0);
                acc += crv[e] * (lr[e] * br - li[e] * bi) - civ[e] * (lr[e] * bi + li[e] * br); }
        }
        if (j == 0 && h >= hp0 && h < hp0 + 4) acc[h - hp0] += a.in[I_S5D][g * 16 + h];
        *(f32x4*)(KJ + ((size_t)(g * 8 + j) * 16 + h) * 16 + hp0) = acc;
    }
}
#define LDS_BARRIER() do { asm volatile("s_waitcnt lgkmcnt(0)" ::: "memory"); __builtin_amdgcn_s_barrier(); asm volatile("" ::: "memory"); } while (0)
__device__ __forceinline__ void s5_unit(Frame& F, const Args& a, int unit) {
    unsigned char* ws = a.ws;
    const int g = unit >> 1, half = unit & 1;
    int l_ = F.lane; asm volatile("" : "+v"(l_));
    const int w = F.wave, l = l_, c16 = l & 15, q = l >> 4, tid = w * 64 + l;
    LAS float* SL = (LAS float*)(F.lds);
    LAS bf16* SP = (LAS bf16*)(F.lds + 33792);
    const float2* LAM = (const float2*)(ws + WS_LAM); const float* BBR = (const float*)(ws + WS_BBR); const float* BBI = (const float*)(ws + WS_BBI); const float* KJ = (const float*)(ws + WS_KJ);
    const bf16* Ug = (const bf16*)(ws + WS_UG) + (size_t)g * (MROWS * 16);
    bf16* Gout = (bf16*)(ws + WS_G);
    bf16x8 m2f[4], m13f[8];
    {
        const int n = 16 * w + c16, p = n & 63; const float sgn = (n >= 64) ? 1.f : 0.f;
#pragma unroll
        for (int ks = 0; ks < 4; ++ks) {
            const int tau = 2 * ks + (q >> 1), h0 = 8 * (q & 1);
            const float2 L = LAM[(g * 9 + (7 - tau)) * 64 + p];
            const f32x4 br0 = *(const f32x4*)(BBR + (g * 64 + p) * 16 + h0), br1 = *(const f32x4*)(BBR + (g * 64 + p) * 16 + h0 + 4), bi0 = *(const f32x4*)(BBI + (g * 64 + p) * 16 + h0), bi1 = *(const f32x4*)(BBI + (g * 64 + p) * 16 + h0 + 4);
            const f32x4 A0 = sgn * bi0 + (1.f - sgn) * br0, A1 = sgn * bi1 + (1.f - sgn) * br1, B0 = sgn * br0 - (1.f - sgn) * bi0, B1 = sgn * br1 - (1.f - sgn) * bi1;
            const f32x4 v0 = L.x * A0 + L.y * B0, v1 = L.x * A1 + L.y * B1;
            float v[8] = {v0.x, v0.y, v0.z, v0.w, v1.x, v1.y, v1.z, v1.w};
            m2f[ks] = __builtin_bit_cast(bf16x8, pack8f(v));
            if (ks & 1) asm volatile("" ::: "memory");
        }
#pragma unroll
        for (int ks = 0; ks < 4; ++ks) {
            const int tau = 2 * ks + (q >> 1), h0 = 8 * (q & 1); const float on = (tau <= w) ? 1.f : 0.f; const int jj = (tau <= w) ? (w - tau) : 0;
            const f32x4 k0 = *(const f32x4*)(KJ + ((g * 8 + jj) * 16 + c16) * 16 + h0), k1 = *(const f32x4*)(KJ + ((g * 8 + jj) * 16 + c16) * 16 + h0 + 4);
            float v[8] = {on * k0.x, on * k0.y, on * k0.z, on * k0.w, on * k1.x, on * k1.y, on * k1.z, on * k1.w};
            m13f[ks] = __builtin_bit_cast(bf16x8, pack8f(v));
        }
#pragma unroll
        for (int ks = 4; ks < 8; ++ks) {
            const int kk = 32 * (ks - 4) + 8 * q, p0 = kk & 63; const float sg2 = (kk >= 64) ? 1.f : 0.f;
            const f32x4* Lp = (const f32x4*)(LAM + (g * 9 + (w + 1)) * 64 + p0);
            const f32x4 l0 = Lp[0], l1 = Lp[1], l2 = Lp[2], l3 = Lp[3];
            const f32x4 c0 = *(const f32x4*)(a.in[I_CRE] + (g * 16 + c16) * 64 + p0), c1 = *(const f32x4*)(a.in[I_CRE] + (g * 16 + c16) * 64 + p0 + 4);
            const f32x4 d0 = *(const f32x4*)(a.in[I_CIM] + (g * 16 + c16) * 64 + p0), d1 = *(const f32x4*)(a.in[I_CIM] + (g * 16 + c16) * 64 + p0 + 4);
            const float Lr[8] = {l0.x, l0.z, l1.x, l1.z, l2.x, l2.z, l3.x, l3.z}, Li[8] = {l0.y, l0.w, l1.y, l1.w, l2.y, l2.w, l3.y, l3.w};
            const float cr[8] = {c0.x, c0.y, c0.z, c0.w, c1.x, c1.y, c1.z, c1.w}, ci[8] = {d0.x, d0.y, d0.z, d0.w, d1.x, d1.y, d1.z, d1.w};
            float v[8];
#pragma unroll
            for (int j = 0; j < 8; ++j) { const float re = cr[j] * Lr[j] - ci[j] * Li[j], im = -(cr[j] * Li[j] + ci[j] * Lr[j]); v[j] = sg2 * im + (1.f - sg2) * re; }
            m13f[ks] = __builtin_bit_cast(bf16x8, pack8f(v));
            asm volatile("" ::: "memory");
        }
    }
    const float2 L8 = LAM[(g * 9 + 8) * 64 + l];
    LAS float* LE = (LAS float*)(F.lds + 51200);
    float pwr[8], pwi[8], p8r, p8i;
    { float cr = 1.f, ci = 0.f;
#pragma unroll
      for (int i = 0; i < 8; ++i) { pwr[i] = cr; pwi[i] = ci; const float nr = cr * L8.x - ci * L8.y, ni = cr * L8.y + ci * L8.x; cr = nr; ci = ni; }
      p8r = cr; p8i = ci; }
    float sr = 0.f, si = 0.f;
    LAS bf16* UT = (LAS bf16*)(F.lds + 55296);
    v4u un[2];
#define S5_CROW0(bb) (((bb) == 8) ? (1024 + 64 * half) : ((2 * half + ((bb) >> 2)) * 256 + ((bb) & 3) * 64))
#define S5_LOADU(bb) do { const bf16* ub_ = Ug + (size_t)S5_CROW0(bb) * 128; _Pragma("unroll") for (int i = 0; i < 2; ++i) un[i] = *(const v4u*)(ub_ + (size_t)(tid + 512 * i) * 8); } while (0)
    S5_LOADU(0);
    for (int blk = 0; blk < 9; ++blk) {
        const bool samp = (blk == 8);
        const int bseq = 2 * half + (blk >> 2);
        const int crow0 = S5_CROW0(blk);
#pragma unroll
        for (int i = 0; i < 2; ++i) { const int idx = tid + 512 * i; *(LAS v4u*)(UT + (idx >> 4) * 136 + 8 * (idx & 15)) = un[i]; }
        if (blk < 8) S5_LOADU(blk + 1);
        LDS_BARRIER();
        bf16x8 uf[4][4];
#pragma unroll
        for (int mt = 0; mt < 4; ++mt)
#pragma unroll
            for (int ks = 0; ks < 4; ++ks) uf[mt][ks] = *(const LAS bf16x8*)(UT + (16 * mt + c16) * 136 + 32 * ks + 8 * q);
        f32x4 acc[4];
#pragma unroll
        for (int mt = 0; mt < 4; ++mt) { acc[mt] = (f32x4){0.f, 0.f, 0.f, 0.f};
#pragma unroll
            for (int ks = 0; ks < 4; ++ks) acc[mt] = mfma16(uf[mt][ks], m2f[ks], acc[mt]); }
#pragma unroll
        for (int mt = 0; mt < 4; ++mt)
#pragma unroll
            for (int r = 0; r < 4; ++r) SL[(16 * mt + 4 * q + r) * 132 + 16 * w + c16] = acc[mt][r];
        __syncthreads();
        if (!samp) {
            if ((blk & 3) == 0) { sr = 0.f; si = 0.f; }
            float elr[8], eli[8]; float er = 0.f, ei = 0.f;
#pragma unroll
            for (int i = 0; i < 8; ++i) { elr[i] = er; eli[i] = ei; const float ar = SL[(8 * w + i) * 132 + l], ai = SL[(8 * w + i) * 132 + 64 + l];
                const float nr = L8.x * er - L8.y * ei + ar, ni = L8.x * ei + L8.y * er + ai; er = nr; ei = ni; }
            LE[w * 128 + l] = er; LE[w * 128 + 64 + l] = ei;
            LDS_BARRIER();
            float swr = 0.f, swi = 0.f;
#pragma unroll
            for (int ww = 0; ww < 8; ++ww) { if (ww == w) { swr = sr; swi = si; }
                const float ar = LE[ww * 128 + l], ai = LE[ww * 128 + 64 + l];
                const float nr = p8r * sr - p8i * si + ar, ni = p8r * si + p8i * sr + ai; sr = nr; si = ni; }
#pragma unroll
            for (int i = 0; i < 8; ++i) { SP[(8 * w + i) * 136 + l] = f2bf1(elr[i] + pwr[i] * swr - pwi[i] * swi); SP[(8 * w + i) * 136 + 64 + l] = f2bf1(eli[i] + pwr[i] * swi + pwi[i] * swr); }
            if ((blk & 3) == 3 && w == 0) { a.out[O_PS5RE + (size_t)(bseq * 128 + g) * 64 + l] = sr; a.out[O_PS5IM + (size_t)(bseq * 128 + g) * 64 + l] = si; }
        } else {
#pragma unroll
            for (int it = 0; it < 2; ++it) {
                const int idx = tid + 512 * it, r = idx >> 4, p = 4 * (idx & 15), sb = 64 * half + r;
                const size_t so = (size_t)(sb * 128 + g) * 64 + p;
                const f32x4 s0r = *(const f32x4*)(a.in[I_S5RE] + so), s0i = *(const f32x4*)(a.in[I_S5IM] + so);
                const f32x4 l0 = *(const f32x4*)(LAM + (g * 9 + 8) * 64 + p), l1 = *(const f32x4*)(LAM + (g * 9 + 8) * 64 + p + 2);
                const f32x4 lr = (f32x4){l0.x, l0.z, l1.x, l1.z}, li = (f32x4){l0.y, l0.w, l1.y, l1.w};
                *(LAS unsigned long long*)(SP + r * 136 + p) = (unsigned long long)pk2(s0r.x, s0r.y) | ((unsigned long long)pk2(s0r.z, s0r.w) << 32);
                *(LAS unsigned long long*)(SP + r * 136 + 64 + p) = (unsigned long long)pk2(s0i.x, s0i.y) | ((unsigned long long)pk2(s0i.z, s0i.w) << 32);
                const f32x4 ar = *(const LAS f32x4*)(SL + r * 132 + p), ai = *(const LAS f32x4*)(SL + r * 132 + 64 + p);
                *(f32x4*)(a.out + O_SS5RE + so) = lr * s0r - li * s0i + ar;
                *(f32x4*)(a.out + O_SS5IM + so) = lr * s0i + li * s0r + ai;
            }
        }
        __syncthreads();
#pragma unroll
        for (int mt = 0; mt < 4; ++mt) {
            f32x4 y = (f32x4){0.f, 0.f, 0.f, 0.f};
#pragma unroll
            for (int ks = 0; ks < 4; ++ks) y = mfma16(m13f[ks], uf[mt][ks], y);
#pragma unroll
            for (int ks = 4; ks < 8; ++ks) { const bf16x8 spf = *(const LAS bf16x8*)(SP + (16 * mt + c16) * 136 + 32 * (ks - 4) + 8 * q); y = mfma16(m13f[ks], spf, y); }
            const size_t row = (size_t)8 * (crow0 + 16 * mt + c16) + w;
            const unsigned lo = pk2(gelu_tanh_f(y[0]), gelu_tanh_f(y[1])), hi = pk2(gelu_tanh_f(y[2]), gelu_tanh_f(y[3]));
            *(unsigned long long*)(Gout + row * 2048 + g * 16 + 4 * q) = (unsigned long long)lo | ((unsigned long long)hi << 32);
        }
        __syncthreads();
    }
}
__device__ __forceinline__ void conv_wave_item(Frame& F, const Args& a, int item) {
    unsigned char* ws = a.ws;
    const int cb = item & 31, tb = (item >> 5) & 63, b = item >> 11;
    const int l = F.lane, o = l & 15, seg = l >> 4, col = cb * 128 + 8 * o, t0 = 32 * tb + 8 * seg;
    const bf16* XBC = (const bf16*)(ws + WS_XBC); bf16* XC = (bf16*)(ws + WS_XC);
    const float* cw = a.in[I_CONVW];
    float w[4][8], bias[8];
#pragma unroll
    for (int k = 0; k < 4; ++k) { const f32x4 w0 = *(const f32x4*)(cw + k * 4096 + col), w1 = *(const f32x4*)(cw + k * 4096 + col + 4);
        w[k][0] = w0.x; w[k][1] = w0.y; w[k][2] = w0.z; w[k][3] = w0.w; w[k][4] = w1.x; w[k][5] = w1.y; w[k][6] = w1.z; w[k][7] = w1.w; }
    { const f32x4 b0 = *(const f32x4*)(a.in[I_CONVB] + col), b1 = *(const f32x4*)(a.in[I_CONVB] + col + 4); bias[0] = b0.x; bias[1] = b0.y; bias[2] = b0.z; bias[3] = b0.w; bias[4] = b1.x; bias[5] = b1.y; bias[6] = b1.z; bias[7] = b1.w; }
    const size_t rowbase = (size_t)b * 2048 + t0;
    v4u raw[11];
#pragma unroll
    for (int i = 0; i < 11; ++i) { const int tk = t0 - 3 + i; raw[i] = tk >= 0 ? *(const v4u*)(XBC + (rowbase - 3 + i) * 4096 + col) : (v4u){0u, 0u, 0u, 0u}; }
    if (tb == 63 && seg == 3) {
#pragma unroll
        for (int k = 0; k < 3; ++k) { float r[8]; unpack8(raw[8 + k], r); float* dst = a.out + O_PCONV + (size_t)(b * 3 + k) * 4096 + col;
            *(f32x4*)dst = (f32x4){r[0], r[1], r[2], r[3]}; *(f32x4*)(dst + 4) = (f32x4){r[4], r[5], r[6], r[7]}; }
    }
    float r0[8], r1[8], r2[8], r3[8];
    unpack8(raw[0], r0); unpack8(raw[1], r1); unpack8(raw[2], r2);
#pragma unroll
    for (int r = 0; r < 8; ++r) {
        unpack8(raw[3 + r], r3);
        float v[8];
#pragma unroll
        for (int j = 0; j < 8; ++j) { v[j] = silu_f(bias[j] + w[0][j] * r0[j] + w[1][j] * r1[j] + w[2][j] * r2[j] + w[3][j] * r3[j]); r0[j] = r1[j]; r1[j] = r2[j]; r2[j] = r3[j]; }
        *(v4u*)(XC + (rowbase + r) * 4096 + col) = pack8f(v);
    }
}
__device__ __forceinline__ void dt_wave_item(Frame& F, const Args& a, int item) {
    unsigned char* ws = a.ws; const float* DT = (const float*)(ws + WS_DT); float* DTP = (float*)(ws + WS_DTP);
    const int c = item & 15, head = (item >> 4) & 31, b = item >> 9, l = F.lane, row0 = b * 2048 + 128 * c;
    const float Ah = -expf(a.in[I_ALOG][head]), dtb = a.in[I_DTB][head];
    const float d0 = softplus_f(DT[(size_t)(row0 + 2 * l) * 32 + head] + dtb), d1 = softplus_f(DT[(size_t)(row0 + 2 * l + 1) * 32 + head] + dtb);
    const float a0 = d0 * Ah, a1 = d1 * Ah, s = a0 + a1; float incl = s;
#pragma unroll
    for (int off = 1; off < 64; off <<= 1) { const float vv = __shfl_up(incl, off); if (l >= off) incl += vv; }
    const float ac0 = incl - s + a0, ac1 = incl, last = __shfl(incl, 63);
    float* o = DTP + (size_t)item * 128 + 2 * l;
    *(float2*)o = make_float2(d0, d1); *(float2*)(o + 262144) = make_float2(ac0, ac1); *(float2*)(o + 524288) = make_float2(__expf(last - ac0) * d0, __expf(last - ac1) * d1);
}
__device__ __forceinline__ void ssd_prompt_unit(Frame& F, const Args& a, int unit) {
    unsigned char* ws = a.ws;
    const int xcd = unit & 7, slot = unit >> 3, sub = slot & 7, pg = (slot >> 3) * 8 + xcd;
    const int b = pg >> 3, grp = pg & 7, head = grp * 4 + (sub >> 1), ph = sub & 1;
    const int w = F.wave, l = F.lane, c16 = l & 15, q = l >> 4, tid = F.tid;
    LAS bf16* Bc  = (LAS bf16*)(F.lds);
    LAS bf16* Cc  = (LAS bf16*)(F.lds + 34816);
    LAS bf16* Xr  = (LAS bf16*)(F.lds + 69632);
    LAS bf16* Xw  = (LAS bf16*)(F.lds + 79872);
    LAS bf16* Hb  = (LAS bf16*)(F.lds + 90112);
    LAS float* DTs = (LAS float*)(F.lds + 98816);
    LAS float* ACS = DTs + 128; LAS float* WGT = ACS + 128;
    const bf16* Zb = (const bf16*)(ws + WS_Z); const float* DTP = (const float*)(ws + WS_DTP);
    bf16* YG = (bf16*)(ws + WS_YG); float* SSQP = (float*)(ws + WS_SSQP);
    const float Dh = a.in[I_SSDD][head];
    for (int i = tid; i < 32 * 136; i += 512) Hb[i] = 0;
    f32x4 Hacc[2] = {(f32x4){0.f, 0.f, 0.f, 0.f}, (f32x4){0.f, 0.f, 0.f, 0.f}};
    v4u sb[4], sc[4], sx; unsigned short zq[4][2]; float dr0 = 0.f, dr1 = 0.f, dr2 = 0.f;
    const unsigned offA = (unsigned)((tid >> 4) * 8192 + (tid & 15) * 16), offX = (unsigned)((tid >> 2) * 8192 + (tid & 3) * 16), offZ = (unsigned)((16 * w + 4 * q) * 4096 + c16 * 2), offD = (unsigned)(l * 256);
#define SSD_PREFETCH(cc) do { \
        const char* xc = (const char*)(ws + WS_XC) + ((size_t)(b * 2048 + 128 * (cc)) * 4096 + 2048 + grp * 128) * 2;     \
        const char* xx = (const char*)(ws + WS_XC) + ((size_t)(b * 2048 + 128 * (cc)) * 4096 + head * 64 + ph * 32) * 2; \
        _Pragma("unroll") for (int i = 0; i < 4; ++i) { sb[i] = *(const v4u*)(xc + i * 262144 + offA); sc[i] = *(const v4u*)(xc + i * 262144 + 2048 + offA); } \
        sx = *(const v4u*)(xx + offX); \
        if (tid < 128) { const float* dp = DTP + ((size_t)((b * 32 + head) * 16 + (cc))) * 128 + tid; dr0 = dp[0]; dr1 = dp[262144]; dr2 = dp[524288]; } } while (0)
    SSD_PREFETCH(0);
    __syncthreads();
    for (int c = 0; c < 16; ++c) {
        const int row0 = b * 2048 + 128 * c;
#pragma unroll
        for (int i = 0; i < 4; ++i) { const int idx = i * 512 + tid, r = idx >> 4, u = idx & 15;
            *(LAS v4u*)(Bc + r * 136 + 8 * u) = sb[i]; *(LAS v4u*)(Cc + r * 136 + 8 * u) = sc[i]; }
        *(LAS v4u*)(Xr + (tid >> 2) * 40 + 8 * (tid & 3)) = sx;
        if (tid < 128) { DTs[tid] = dr0; ACS[tid] = dr1; WGT[tid] = dr2; }
        LDS_BARRIER();
        {
            const char* zb = (const char*)Zb + ((size_t)row0 * 2048 + head * 64 + ph * 32) * 2;
#pragma unroll
            for (int r = 0; r < 4; ++r)
#pragma unroll
                for (int pt = 0; pt < 2; ++pt) zq[r][pt] = *(const unsigned short*)(zb + r * 4096 + pt * 32 + offZ);
        }
        asm volatile("" ::: "memory");
        if (c < 15) SSD_PREFETCH(c + 1);
        {
            float xr[8]; unpack8(*(const LAS v4u*)(Xr + (tid >> 2) * 40 + 8 * (tid & 3)), xr); const float g = WGT[tid >> 2];
#pragma unroll
            for (int j = 0; j < 8; ++j) xr[j] *= g;
            *(LAS v4u*)(Xw + (tid >> 2) * 40 + 8 * (tid & 3)) = pack8f(xr);
        }
        bf16x8 cf[4];
#pragma unroll
        for (int ks = 0; ks < 4; ++ks) cf[ks] = *(const LAS bf16x8*)(Cc + (16 * w + c16) * 136 + 32 * ks + 8 * q);
        const int lrow = 16 * w + c16; const float acl = ACS[lrow];
        f32x4 yd[2] = {(f32x4){0.f, 0.f, 0.f, 0.f}, (f32x4){0.f, 0.f, 0.f, 0.f}}, yo[2] = {(f32x4){0.f, 0.f, 0.f, 0.f}, (f32x4){0.f, 0.f, 0.f, 0.f}};
#pragma unroll
        for (int Tp = 0; Tp < 4; ++Tp) {
            if (2 * Tp <= w) {
                f32x4 cbt[2] = {(f32x4){0.f, 0.f, 0.f, 0.f}, (f32x4){0.f, 0.f, 0.f, 0.f}};
#pragma unroll
                for (int ks = 0; ks < 4; ++ks) { const bf16x8 bfr = *(const LAS bf16x8*)(Bc + (32 * Tp + c16) * 136 + 32 * ks + 8 * q); cbt[0] = mfma16(bfr, cf[ks], cbt[0]); }
                if (2 * Tp + 1 <= w) {
#pragma unroll
                    for (int ks = 0; ks < 4; ++ks) { const bf16x8 bfr = *(const LAS bf16x8*)(Bc + (32 * Tp + 16 + c16) * 136 + 32 * ks + 8 * q); cbt[1] = mfma16(bfr, cf[ks], cbt[1]); } }
                float e[8];
#pragma unroll
                for (int hf = 0; hf < 2; ++hf) { const int s0 = 16 * (2 * Tp + hf) + 4 * q;
                    const f32x4 as = *(const LAS f32x4*)(ACS + s0), ds = *(const LAS f32x4*)(DTs + s0);
#pragma unroll
                    for (int r = 0; r < 4; ++r) e[4 * hf + r] = (s0 + r <= lrow) ? cbt[hf][r] * __expf(acl - as[r]) * ds[r] : 0.f; }
                const bf16x8 wf = __builtin_bit_cast(bf16x8, pack8f(e));
#pragma unroll
                for (int pt = 0; pt < 2; ++pt) {
                    const unsigned xa = (unsigned)(size_t)Xr + (unsigned)(((32 * Tp + 4 * q + (c16 >> 2)) * 40 + 16 * pt + 4 * (c16 & 3)) * 2);
                    const u16x4_t lo = tr_read(xa), hi = tr_read(xa + 16 * 40 * 2);
                    typedef unsigned short u16x8_t __attribute__((ext_vector_type(8)));
                    const u16x8_t xv = {lo[0], lo[1], lo[2], lo[3], hi[0], hi[1], hi[2], hi[3]};
                    yd[pt] = mfma16(wf, __builtin_bit_cast(bf16x8, xv), yd[pt]); }
            }
        }
#pragma unroll
        for (int pt = 0; pt < 2; ++pt)
#pragma unroll
            for (int ks = 0; ks < 4; ++ks) { const bf16x8 hfr = *(const LAS bf16x8*)(Hb + (16 * pt + c16) * 136 + 32 * ks + 8 * q); yo[pt] = mfma16(cf[ks], hfr, yo[pt]); }
#pragma unroll
        for (int r = 0; r < 4; ++r) {
            const int lr = 16 * w + 4 * q + r; const float ea = __expf(ACS[lr]); const size_t rowg = (size_t)(row0 + lr); float ss = 0.f;
#pragma unroll
            for (int pt = 0; pt < 2; ++pt) { const int p = 16 * pt + c16; const float xv = bf2f(Xr[lr * 40 + p]);
                const float y = yd[pt][r] + ea * yo[pt][r] + Dh * xv; const float yg = y * silu_f(bf2f(zq[r][pt])); ss += yg * yg; YG[rowg * 2048 + head * 64 + ph * 32 + p] = f2bf1(yg); }
            ss += __shfl_xor(ss, 1); ss += __shfl_xor(ss, 2); ss += __shfl_xor(ss, 4); ss += __shfl_xor(ss, 8);
            if (c16 == 0) SSQP[rowg * 64 + head * 2 + ph] = ss;
        }
        LDS_BARRIER();
        {
            const float dec = __expf(ACS[127]);
            Hacc[0] = Hacc[0] * dec; Hacc[1] = Hacc[1] * dec;
#pragma unroll
            for (int ks = 0; ks < 4; ++ks) {
                const bf16x8 bfr = tr_frag((unsigned)(size_t)Bc, 136, 32 * ks, 16 * w, l);
#pragma unroll
                for (int pt = 0; pt < 2; ++pt) { const bf16x8 xwf = tr_frag((unsigned)(size_t)Xw, 40, 32 * ks, 16 * pt, l); Hacc[pt] = mfma16(xwf, bfr, Hacc[pt]); }
            }
#pragma unroll
            for (int pt = 0; pt < 2; ++pt)
#pragma unroll
                for (int r = 0; r < 4; ++r) Hb[(16 * pt + 4 * q + r) * 136 + 16 * w + c16] = f2bf1(Hacc[pt][r]);
            if (c == 15) {
#pragma unroll
                for (int pt = 0; pt < 2; ++pt)
#pragma unroll
                    for (int r = 0; r < 4; ++r) a.out[O_PSSD + ((size_t)(b * 32 + head) * 64 + ph * 32 + 16 * pt + 4 * q + r) * 128 + 16 * w + c16] = Hacc[pt][r];
            }
        }
        LDS_BARRIER();
    }
    __syncthreads();
#undef SSD_PREFETCH
}
__device__ __forceinline__ void ssd_sample_units(Frame& F, const Args& a) {
    unsigned char* ws = a.ws;
    const int w = F.wave, l = F.lane, c16 = l & 15, q = l >> 4, tid = F.tid;
    LAS float* XS = (LAS float*)(F.lds);
    LAS float* BS = XS + 2048;
    LAS float* CS = BS + 1024;
    LAS float* YS = CS + 1024;
    LAS float* DTS = YS + 2048;
    LAS float* DAS = DTS + 32;
    const bf16* XBC = (const bf16*)(ws + WS_XBC); const bf16* Zb = (const bf16*)(ws + WS_Z); const float* DT = (const float*)(ws + WS_DT);
    bf16* MIX = (bf16*)(ws + WS_MIX);
    const int hl = w >> 1, pbase = 32 * (w & 1), ch = tid;
    f32x4 Hn[2][8], pnw = (f32x4){0.f, 0.f, 0.f, 0.f}; float pr0 = 0.f, pr1 = 0.f, pr2 = 0.f, pw0 = 0.f, pw1 = 0.f, pw2 = 0.f, pw3 = 0.f, pcb = 0.f, pdt = 0.f, pdb = 0.f, pal = 0.f, pdh = 0.f;
    unsigned short px[8]; unsigned pz0 = 0u, pz1 = 0u, pz2 = 0u, pz3 = 0u;
#define SMP_PREFETCH(uu) do { const int sbn = (uu) >> 3, grpn = (uu) & 7, R0n = MP + 8 * sbn, headn = grpn * 4 + hl; \
        const int coln = ch < 256 ? grpn * 256 + ch : (ch < 384 ? 2048 + grpn * 128 + (ch - 256) : 3072 + grpn * 128 + (ch - 384)); \
        const float* cw = a.in[I_CONVW]; pw0 = cw[coln]; pw1 = cw[4096 + coln]; pw2 = cw[8192 + coln]; pw3 = cw[12288 + coln]; pcb = a.in[I_CONVB][coln]; \
        const float* st = a.in[I_SCONV] + (size_t)sbn * 3 * 4096 + coln; pr0 = st[0]; pr1 = st[4096]; pr2 = st[8192]; \
        _Pragma("unroll") for (int t = 0; t < 8; ++t) px[t] = XBC[(size_t)(R0n + t) * 4096 + coln]; \
        if (tid < 32) { const int hd = grpn * 4 + (tid & 3); pdt = DT[(size_t)(R0n + (tid >> 2)) * 32 + hd]; pdb = a.in[I_DTB][hd]; pal = a.in[I_ALOG][hd]; } \
        { const size_t zo_ = (size_t)(R0n + q) * 2048 + headn * 64 + pbase + c16; pz0 = Zb[zo_]; pz1 = Zb[zo_ + 16]; pz2 = Zb[zo_ + 4 * 2048]; pz3 = Zb[zo_ + 4 * 2048 + 16]; } \
        pdh = a.in[I_SSDD][headn]; pnw = *(const f32x4*)(a.in[I_NORMW] + grpn * 256 + 4 * l); \
        const float* hin = a.in[I_SSSD] + (size_t)(sbn * 32 + headn) * 64 * 128; \
        _Pragma("unroll") for (int pt = 0; pt < 2; ++pt) _Pragma("unroll") for (int ks = 0; ks < 8; ++ks) Hn[pt][ks] = *(const f32x4*)(hin + (size_t)(pbase + 16 * pt + c16) * 128 + 16 * ks + 4 * q); } while (0)
    int u = blockIdx.x;
    if (u < 1024) SMP_PREFETCH(u);
    for (; u < 1024; u += F.G) {
        const int sb = u >> 3, grp = u & 7, R0 = MP + 8 * sb, head = grp * 4 + hl;
        {
            const int col = ch < 256 ? grp * 256 + ch : (ch < 384 ? 2048 + grp * 128 + (ch - 256) : 3072 + grp * 128 + (ch - 384));
            float r0 = pr0, r1 = pr1, r2 = pr2;
            LAS float* dst = ch < 256 ? XS + ch : (ch < 384 ? BS + (ch - 256) : CS + (ch - 384)); const int pitch = ch < 256 ? 256 : 128;
#pragma unroll
            for (int t = 0; t < 8; ++t) { const float r3 = bf2f(px[t]);
                dst[t * pitch] = silu_f(pcb + pw0 * r0 + pw1 * r1 + pw2 * r2 + pw3 * r3);
                if (t >= 5) a.out[O_SCONV + (size_t)(sb * 3 + (t - 5)) * 4096 + col] = r3;
                r0 = r1; r1 = r2; r2 = r3; }
            if (tid < 32) { const float dd = softplus_f(pdt + pdb); DTS[tid] = dd; DAS[tid] = __expf(-dd * expf(pal)); }
        }
        f32x4 H[2][8];
#pragma unroll
        for (int pt = 0; pt < 2; ++pt)
#pragma unroll
            for (int ks = 0; ks < 8; ++ks) H[pt][ks] = Hn[pt][ks];
        const unsigned zc[4] = {pz0, pz1, pz2, pz3}; const float Dh = pdh; const f32x4 nw = pnw;
        LDS_BARRIER();
        SMP_PREFETCH((u + F.G < 1024) ? u + F.G : u);
        {
            float* hout = a.out + O_SSSD + (size_t)(sb * 32 + head) * 64 * 128;
#pragma unroll
            for (int t = 0; t < 8; ++t) {
                const float dA = DAS[t * 4 + hl], dtv = DTS[t * 4 + hl];
                const float x0 = XS[t * 256 + hl * 64 + pbase + c16], x1 = XS[t * 256 + hl * 64 + pbase + 16 + c16];
                const float xd0 = x0 * dtv, xd1 = x1 * dtv; float y0 = 0.f, y1 = 0.f;
#pragma unroll
                for (int ks = 0; ks < 8; ++ks) { const f32x4 b4 = *(const LAS f32x4*)(BS + t * 128 + 16 * ks + 4 * q), c4 = *(const LAS f32x4*)(CS + t * 128 + 16 * ks + 4 * q);
                    H[0][ks] = H[0][ks] * dA + b4 * xd0; H[1][ks] = H[1][ks] * dA + b4 * xd1;
                    y0 += (c4.x * H[0][ks].x + c4.y * H[0][ks].y) + (c4.z * H[0][ks].z + c4.w * H[0][ks].w);
                    y1 += (c4.x * H[1][ks].x + c4.y * H[1][ks].y) + (c4.z * H[1][ks].z + c4.w * H[1][ks].w); }
                y0 += __shfl_xor(y0, 16); y0 += __shfl_xor(y0, 32); y1 += __shfl_xor(y1, 16); y1 += __shfl_xor(y1, 32);
                if (q == (t & 3)) { YS[t * 256 + hl * 64 + pbase + c16] = (y0 + Dh * x0) * silu_f(__uint_as_float(zc[2 * (t >> 2)] << 16)); YS[t * 256 + hl * 64 + pbase + 16 + c16] = (y1 + Dh * x1) * silu_f(__uint_as_float(zc[2 * (t >> 2) + 1] << 16)); }
            }
            asm volatile("" :: "v"((unsigned)px[0]), "v"((unsigned)px[1]), "v"((unsigned)px[2]), "v"((unsigned)px[3]), "v"((unsigned)px[4]), "v"((unsigned)px[5]), "v"((unsigned)px[6]), "v"((unsigned)px[7]),
                         "v"(pr0), "v"(pr1), "v"(pr2), "v"(pw0), "v"(pw1), "v"(pw2), "v"(pw3), "v"(pcb), "v"(pdt), "v"(pdb), "v"(pal), "v"(pz0), "v"(pz1), "v"(pz2), "v"(pz3), "v"(pdh), "v"(pnw) : "memory");
            asm volatile("" :: "v"(Hn[0][0]), "v"(Hn[0][1]), "v"(Hn[0][2]), "v"(Hn[0][3]), "v"(Hn[0][4]), "v"(Hn[0][5]), "v"(Hn[0][6]), "v"(Hn[0][7]),
                         "v"(Hn[1][0]), "v"(Hn[1][1]), "v"(Hn[1][2]), "v"(Hn[1][3]), "v"(Hn[1][4]), "v"(Hn[1][5]), "v"(Hn[1][6]), "v"(Hn[1][7]) : "memory");
#pragma unroll
            for (int pt = 0; pt < 2; ++pt)
#pragma unroll
                for (int ks = 0; ks < 8; ++ks) *(f32x4*)(hout + (size_t)(pbase + 16 * pt + c16) * 128 + 16 * ks + 4 * q) = H[pt][ks];
        }
        LDS_BARRIER();
        {
            const f32x4 yv = *(const LAS f32x4*)(YS + w * 256 + 4 * l);
            const float ss = wave_sum((yv.x * yv.x + yv.y * yv.y) + (yv.z * yv.z + yv.w * yv.w));
            const float rstd = 1.0f / sqrtf(ss * (1.f / 256.f) + EPS);
            *(unsigned long long*)(MIX + (size_t)(R0 + w) * 4096 + 2048 + grp * 256 + 4 * l) = (unsigned long long)pk2(yv.x * rstd * nw.x, yv.y * rstd * nw.y) | ((unsigned long long)pk2(yv.z * rstd * nw.z, yv.w * rstd * nw.w) << 32);
        }
        LDS_BARRIER();
    }
    __syncthreads();
#undef SMP_PREFETCH
}
__device__ __forceinline__ void p3_ssd_norm(Frame& F, const Args& a, int gw, int NGW) {
    unsigned char* ws = a.ws;
    const bf16* YG = (const bf16*)(ws + WS_YG); const float* SSQP = (const float*)(ws + WS_SSQP); bf16* MIX = (bf16*)(ws + WS_MIX);
    const int l = F.lane;
    for (int m = gw; m < MP; m += NGW) {
#pragma unroll
        for (int i = 0; i < 4; ++i) {
            const int c = 8 * (l + 64 * i), grp = c >> 8;
            const f32x4 s0 = *(const f32x4*)(SSQP + (size_t)m * 64 + grp * 8), s1 = *(const f32x4*)(SSQP + (size_t)m * 64 + grp * 8 + 4);
            const float rstd = 1.0f / sqrtf(((s0.x + s0.y) + (s0.z + s0.w) + (s1.x + s1.y) + (s1.z + s1.w)) * (1.f / 256.f) + EPS);
            float v[8]; unpack8(*(const v4u*)(YG + (size_t)m * 2048 + c), v);
            const f32x4 n0 = *(const f32x4*)(a.in[I_NORMW] + c), n1 = *(const f32x4*)(a.in[I_NORMW] + c + 4);
            v[0] *= rstd * n0.x; v[1] *= rstd * n0.y; v[2] *= rstd * n0.z; v[3] *= rstd * n0.w; v[4] *= rstd * n1.x; v[5] *= rstd * n1.y; v[6] *= rstd * n1.z; v[7] *= rstd * n1.w;
            *(v4u*)(MIX + (size_t)m * 4096 + 2048 + c) = pack8f(v);
        }
    }
}
__device__ __forceinline__ f32x4 tail_sum(const float* PART, int m, int j, unsigned lo) {
    const char* p = (const char*)((const bf16*)PART + ((size_t)((m - MP) >> 8) * 16 + j) * 65536 + (size_t)((m - MP) & 255) * 256) + lo;
    const v2u p0 = *(const v2u*)p, p1 = *(const v2u*)(p + (size_t)64 * 131072), p2 = *(const v2u*)(p + (size_t)128 * 131072), p3 = *(const v2u*)(p + (size_t)192 * 131072);
    const f32x4 a0 = (f32x4){__uint_as_float(p0.x << 16), __uint_as_float(p0.x & 0xffff0000u), __uint_as_float(p0.y << 16), __uint_as_float(p0.y & 0xffff0000u)};
    const f32x4 a1 = (f32x4){__uint_as_float(p1.x << 16), __uint_as_float(p1.x & 0xffff0000u), __uint_as_float(p1.y << 16), __uint_as_float(p1.y & 0xffff0000u)};
    const f32x4 a2 = (f32x4){__uint_as_float(p2.x << 16), __uint_as_float(p2.x & 0xffff0000u), __uint_as_float(p2.y << 16), __uint_as_float(p2.y & 0xffff0000u)};
    const f32x4 a3 = (f32x4){__uint_as_float(p3.x << 16), __uint_as_float(p3.x & 0xffff0000u), __uint_as_float(p3.y << 16), __uint_as_float(p3.y & 0xffff0000u)};
    return (a0 + a1) + (a2 + a3);
}
#define ROW_F4(rowp, j) (*(const f32x4*)((const char*)(rowp) + offq[(j) >> 2] + ((j) & 3) * 1024))
#define ROW_H4(rowp, j) (*(const v2u*)((const char*)(rowp) + offh[(j) >> 3] + ((j) & 7) * 512))
#define ROW_F4W(rowp, j) (*(f32x4*)((char*)(rowp) + offq[(j) >> 2] + ((j) & 3) * 1024))
#define ROW_H4W(rowp, j) (*(unsigned long long*)((char*)(rowp) + offh[(j) >> 3] + ((j) & 7) * 512))
__device__ __forceinline__ f32x4 unpk4(const v2u w) { return (f32x4){__uint_as_float(w.x << 16), __uint_as_float(w.x & 0xffff0000u), __uint_as_float(w.y << 16), __uint_as_float(w.y & 0xffff0000u)}; }
__device__ __forceinline__ void p5_row_finish(const LAS unsigned char* glds, f32x4 (&v)[16], const f32x4 (&xv)[16], bf16* x1row, bf16* hnrow, const unsigned (&offq)[4], const unsigned (&offh)[2]) {
    float s = 0.f;
#pragma unroll
    for (int j = 0; j < 16; ++j) s += (v[j].x * v[j].x + v[j].y * v[j].y) + (v[j].z * v[j].z + v[j].w * v[j].w);
    const float rstd1 = 1.0f / sqrtf(wave_sum(s) * (1.f / DM) + EPS); float s2 = 0.f;
#pragma unroll
    for (int j = 0; j < 16; ++j) { if ((j & 3) == 0) asm volatile("" ::: "memory");
        const f32x4 g = *(const LAS f32x4*)(glds + offq[j >> 2] + (j & 3) * 1024);
        v[j] = xv[j] + v[j] * rstd1 * g; s2 += (v[j].x * v[j].x + v[j].y * v[j].y) + (v[j].z * v[j].z + v[j].w * v[j].w);
        ROW_H4W(x1row, j) = (unsigned long long)pk2(v[j].x, v[j].y) | ((unsigned long long)pk2(v[j].z, v[j].w) << 32); }
    const float rstd2 = 1.0f / sqrtf(wave_sum(s2) * (1.f / DM) + EPS);
#pragma unroll
    for (int j = 0; j < 16; ++j) { if ((j & 3) == 0) asm volatile("" ::: "memory");
        const f32x4 g = *(const LAS f32x4*)(glds + 16384 + offq[j >> 2] + (j & 3) * 1024);
        ROW_H4W(hnrow, j) = (unsigned long long)pk2(v[j].x * rstd2 * g.x, v[j].y * rstd2 * g.y) | ((unsigned long long)pk2(v[j].z * rstd2 * g.z, v[j].w * rstd2 * g.w) << 32); }
}
__device__ __forceinline__ void p5_rows(Frame& F, const Args& a) {
    unsigned char* ws = a.ws; const float* PART = (const float*)(ws + WS_PART); const bool split = (F.G == 256);
    const bf16* MIXO = (const bf16*)(ws + WS_MIXO); bf16* HN = (bf16*)(ws + WS_HN);
    const int gw = F.vcu * NWAVES + F.wave, NGW = F.G * NWAVES, l = F.lane;
    unsigned offq[4], offh[2];
#pragma unroll
    for (int k = 0; k < 4; ++k) offq[k] = (unsigned)(l * 16 + 4096 * k);
    offh[0] = (unsigned)(l * 8); offh[1] = (unsigned)(l * 8 + 4096);
    gain_to_lds(F.lds, 0, a.in[I_GPOST], F.tid); gain_to_lds(F.lds, 16384, a.in[I_GFPRE], F.tid);
    __syncthreads();
    const int mend = split ? MP : MROWS;
    v2u mwN[16];
    int m = gw;
    if (m < mend) {
#pragma unroll
        for (int j = 0; j < 16; ++j) mwN[j] = ROW_H4(MIXO + (size_t)m * DM, j); }
    for (; m < mend; m += NGW) {
        f32x4 v[16], xv[16];
        const float* xrow = m < MP ? a.in[I_XP] + (size_t)m * DM : a.in[I_XS] + (size_t)(m - MP) * DM;
#pragma unroll
        for (int j = 0; j < 16; ++j) xv[j] = ROW_F4(xrow, j);
#pragma unroll
        for (int j = 0; j < 16; ++j) v[j] = unpk4(mwN[j]);
        { const int mn = (m + NGW < mend) ? m + NGW : m;
#pragma unroll
            for (int j = 0; j < 16; ++j) mwN[j] = ROW_H4(MIXO + (size_t)mn * DM, j); }
        p5_row_finish(F.lds, v, xv, (bf16*)(ws + WS_X1) + (size_t)m * DM, HN + (size_t)m * DM, offq, offh);
    }
    if (split) for (int mt = MP + gw; mt < MROWS; mt += NGW) {
        f32x4 v[16], xv[16];
#pragma unroll
        for (int j = 0; j < 16; ++j) { v[j] = tail_sum(PART, mt, j, offh[0]); xv[j] = ROW_F4(a.in[I_XS] + (size_t)(mt - MP) * DM, j); }
        p5_row_finish(F.lds, v, xv, (bf16*)(ws + WS_X1) + (size_t)mt * DM, HN + (size_t)mt * DM, offq, offh);
    }
}
__device__ __forceinline__ void p7_conv_geglu(Frame& F, const Args& a) {
    unsigned char* ws = a.ws;
    const bf16* UP = (const bf16*)(ws + WS_UP); bf16* ACT = (bf16*)(ws + WS_ACT);
    const float* cw = a.in[I_FCW]; const float* cb = a.in[I_FCB];
    const int gt = (F.vcu * NWAVES + F.wave) * 64 + F.lane, NT = F.G * NWAVES * 64;
    constexpr int NOC = D_FF / 8, NRB = MROWS / 8;
    const int ngrp = NT / NOC, oc = gt % NOC, grp = gt / NOC;
    if (grp >= ngrp) return;
    const int col = 8 * oc;
    float wg[3][8], wv[3][8], bg[8], bv[8];
#pragma unroll
    for (int j = 0; j < 8; ++j) { bg[j] = cb[col + j]; bv[j] = cb[D_FF + col + j];
#pragma unroll
        for (int k = 0; k < 3; ++k) { wg[k][j] = cw[k * N_UP + col + j]; wv[k][j] = cw[k * N_UP + D_FF + col + j]; } }
    v4u rg[8], rv[8], hh[4];
    const char* upc = (const char*)UP + (size_t)col * 2;
#define P7_ROWP(row) (upc + (size_t)(row) * (N_UP * 2))
#define P7_GLD(dst, p) asm volatile("global_load_dwordx4 %0, %1, off" : "=v"(dst) : "v"(p) : "memory")
#define P7_HALO(row0_) do { const int h2_ = ((row0_) & 2047) ? (row0_) - 2 : (row0_), h1_ = ((row0_) & 2047) ? (row0_) - 1 : (row0_); const char* pa_ = P7_ROWP(h2_); const char* pb_ = P7_ROWP(h1_); \
        P7_GLD(hh[0], pa_); P7_GLD(hh[1], pb_); P7_GLD(hh[2], pa_ + D_FF * 2); P7_GLD(hh[3], pb_ + D_FF * 2); } while (0)
#define P7_ROW(r, row0_) do { float g0[8], v0[8], o[8]; unpack8(rg[r], g0); unpack8(rv[r], v0); \
        _Pragma("unroll") for (int j = 0; j < 8; ++j) { const float gate = bg[j] + wg[0][j] * g2[j] + wg[1][j] * g1[j] + wg[2][j] * g0[j]; const float val = bv[j] + wv[0][j] * v2[j] + wv[1][j] * v1[j] + wv[2][j] * v0[j]; \
            o[j] = gelu_tanh_f(gate) * val; g2[j] = g1[j]; g1[j] = g0[j]; v2[j] = v1[j]; v1[j] = v0[j]; } \
        *(v4u*)(ACT + (size_t)((row0_) + (r)) * D_FF + col) = pack8f(o); } while (0)
    constexpr int NRBP = MP / 8;
#define P7_W8(x) "v"(x[0]), "v"(x[1]), "v"(x[2]), "v"(x[3]), "v"(x[4]), "v"(x[5]), "v"(x[6]), "v"(x[7])
    asm volatile("" :: P7_W8(wg[0]), P7_W8(wg[1]), P7_W8(wg[2]) : "memory");
    asm volatile("" :: P7_W8(wv[0]), P7_W8(wv[1]), P7_W8(wv[2]) : "memory");
    asm volatile("" :: P7_W8(bg), P7_W8(bv) : "memory");
#undef P7_W8
    asm volatile("s_waitcnt vmcnt(0)" ::: "memory");
    {
        const int rb0 = grp < NRBP ? grp : 0;
        P7_HALO(8 * rb0);
#pragma unroll
        for (int r = 0; r < 8; ++r) { const char* pr_ = P7_ROWP(8 * rb0 + r); P7_GLD(rg[r], pr_); P7_GLD(rv[r], pr_ + D_FF * 2); }
    }
    int rb = grp;
#pragma unroll 1
    for (; rb < NRBP; rb += ngrp) {
        const int row0 = 8 * rb, rown = (rb + ngrp < NRBP) ? row0 + 8 * ngrp : row0;
        float g2[8], g1[8], v2[8], v1[8];
        asm volatile("s_waitcnt vmcnt(16)" : "+v"(hh[0]), "+v"(hh[1]), "+v"(hh[2]), "+v"(hh[3]) :: "memory");
        unpack8(hh[0], g2); unpack8(hh[1], g1); unpack8(hh[2], v2); unpack8(hh[3], v1);
        const float keep = (row0 & 2047) ? 1.f : 0.f;
#pragma unroll
        for (int j = 0; j < 8; ++j) { g2[j] *= keep; g1[j] *= keep; v2[j] *= keep; v1[j] *= keep; }
        asm volatile("" :: "v"(g2[0]), "v"(g2[1]), "v"(g2[2]), "v"(g2[3]), "v"(g2[4]), "v"(g2[5]), "v"(g2[6]), "v"(g2[7]), "v"(g1[0]), "v"(g1[1]), "v"(g1[2]), "v"(g1[3]), "v"(g1[4]), "v"(g1[5]), "v"(g1[6]), "v"(g1[7]) : "memory");
        asm volatile("" :: "v"(v2[0]), "v"(v2[1]), "v"(v2[2]), "v"(v2[3]), "v"(v2[4]), "v"(v2[5]), "v"(v2[6]), "v"(v2[7]), "v"(v1[0]), "v"(v1[1]), "v"(v1[2]), "v"(v1[3]), "v"(v1[4]), "v"(v1[5]), "v"(v1[6]), "v"(v1[7]) : "memory");
        P7_HALO(rown);
#pragma unroll
        for (int r = 0; r < 8; ++r) {
            float g0[8], v0[8], o[8];
            asm volatile("s_waitcnt vmcnt(%2)" : "+v"(rg[r]), "+v"(rv[r]) : "n"(18 + r) : "memory");
            unpack8(rg[r], g0); unpack8(rv[r], v0);
            asm volatile("" :: "v"(g0[0]), "v"(g0[1]), "v"(g0[2]), "v"(g0[3]), "v"(g0[4]), "v"(g0[5]), "v"(g0[6]), "v"(g0[7]), "v"(v0[0]), "v"(v0[1]), "v"(v0[2]), "v"(v0[3]), "v"(v0[4]), "v"(v0[5]), "v"(v0[6]), "v"(v0[7]) : "memory");
            { const char* pr_ = P7_ROWP(rown + r); P7_GLD(rg[r], pr_); P7_GLD(rv[r], pr_ + D_FF * 2); }
#pragma unroll
            for (int j = 0; j < 8; ++j) { const float gate = bg[j] + wg[0][j] * g2[j] + wg[1][j] * g1[j] + wg[2][j] * g0[j]; const float val = bv[j] + wv[0][j] * v2[j] + wv[1][j] * v1[j] + wv[2][j] * v0[j];
                o[j] = gelu_tanh_f(gate) * val; g2[j] = g1[j]; g1[j] = g0[j]; v2[j] = v1[j]; v1[j] = v0[j]; }
            *(v4u*)(ACT + (size_t)(row0 + r) * D_FF + col) = pack8f(o);
        }
    }
    asm volatile("s_waitcnt vmcnt(0)" ::: "memory");
#pragma unroll 1
    for (; rb < NRB; rb += ngrp) {
        const int row0 = 8 * rb;
#pragma unroll
        for (int r = 0; r < 8; ++r) { rg[r] = *(const v4u*)P7_ROWP(row0 + r); rv[r] = *(const v4u*)(P7_ROWP(row0 + r) + D_FF * 2); }
        float g2[8], g1[8], v2[8], v1[8];
        const float* st = a.in[I_SFFN] + (size_t)((row0 - MP) >> 3) * 2 * N_UP + col;
#pragma unroll
        for (int h = 0; h < 2; ++h) { const f32x4 a2 = *(const f32x4*)(st + 4 * h), a1 = *(const f32x4*)(st + N_UP + 4 * h), b2 = *(const f32x4*)(st + D_FF + 4 * h), b1 = *(const f32x4*)(st + N_UP + D_FF + 4 * h);
#pragma unroll
            for (int j = 0; j < 4; ++j) { g2[4 * h + j] = a2[j]; g1[4 * h + j] = a1[j]; v2[4 * h + j] = b2[j]; v1[4 * h + j] = b1[j]; } }
#pragma unroll
        for (int r = 0; r < 8; ++r) P7_ROW(r, row0);
    }
#undef P7_ROWP
#undef P7_GLD
#undef P7_HALO
#undef P7_ROW
}
__device__ __forceinline__ void p9_rows(Frame& F, const Args& a) {
    unsigned char* ws = a.ws; const float* PART = (const float*)(ws + WS_PART); const bool split = (F.G == 256);
    const bf16* FFb = (const bf16*)(ws + WS_FF);
    const int gw = F.vcu * NWAVES + F.wave, NGW = F.G * NWAVES, l = F.lane;
    gain_to_lds(F.lds, 0, a.in[I_GFPOST], F.tid);
    __syncthreads();
    for (int m = gw; m < MROWS; m += NGW) {
        f32x4 v[16], x1[16]; float s = 0.f;
        const bool tail = split && m >= MP;
        const v2u* xrow = (const v2u*)((const bf16*)(ws + WS_X1) + (size_t)m * DM);
#pragma unroll
        for (int j = 0; j < 16; ++j) { const v2u xw = xrow[l + 64 * j];
            x1[j] = (f32x4){__uint_as_float(xw.x << 16), __uint_as_float(xw.x & 0xffff0000u), __uint_as_float(xw.y << 16), __uint_as_float(xw.y & 0xffff0000u)}; }
#pragma unroll
        for (int j = 0; j < 16; ++j) {
            if (tail) v[j] = tail_sum(PART, m, j, (unsigned)(l * 8));
            else { const v2u mw = *(const v2u*)(FFb + (size_t)m * DM + 4 * (l + 64 * j));
                v[j] = (f32x4){__uint_as_float(mw.x << 16), __uint_as_float(mw.x & 0xffff0000u), __uint_as_float(mw.y << 16), __uint_as_float(mw.y & 0xffff0000u)}; }
            s += (v[j].x * v[j].x + v[j].y * v[j].y) + (v[j].z * v[j].z + v[j].w * v[j].w); }
        const float rstd = 1.0f / sqrtf(wave_sum(s) * (1.f / DM) + EPS);
        f32x4* orow = (f32x4*)(a.out + O_Y + (size_t)m * DM);
#pragma unroll
        for (int j = 0; j < 16; ++j) { const f32x4 g = ((const LAS f32x4*)F.lds)[l + 64 * j]; orow[l + 64 * j] = x1[j] + v[j] * rstd * g; }
    }
}

__global__ void __launch_bounds__(NWAVES * 64, 2) mk_fwd(Args args) {
    extern __shared__ __attribute__((aligned(16))) unsigned char lds[];
    Frame F;
    F.lds = (LAS unsigned char*)lds;
    volatile LAS unsigned* MISC = (volatile LAS unsigned*)(F.lds + MISC_OFF);
    F.tid = threadIdx.x; F.lane = F.tid & 63; F.wave = __builtin_amdgcn_readfirstlane(F.tid >> 6);
    F.G = gridDim.x; { const int bx = blockIdx.x; F.vcu = (F.G % 8 == 0) ? (bx % 8) * (F.G / 8) + bx / 8 : bx; }
    unsigned char* ws = args.ws;
    unsigned* ctl = (unsigned*)(ws + WS_CTL);
    for (int u = F.tid; u < (LDS_BYTES - MISC_OFF) / 4; u += NWAVES * 64) ((LAS unsigned*)(F.lds + MISC_OFF))[u] = 0u;
    __syncthreads();
    XcdBarrier bar = xcd_barrier_post(ctl + CW_BAR + args.bli * XCD_BAR_WORDS, MISC + 8);
    const int lo = args.ph_lo, hi = args.ph_hi;
#define IN(k) (lo <= (k) && (k) < hi)
#define SEAM(k) do { if (IN(k) && IN((k) + 1)) xcd_barrier(bar); } while (0)

    if (IN(0)) { p0_prologue(F, args); } SEAM(0);
    if (IN(1)) {
        pg8::Gemm g{(const pg8::bf16_t*)(ws + WS_HN), (const pg8::bf16_t*)(ws + WS_WIN), MROWS, N1PAD, DM}; pg8::StaticOrder S; S.init(MROWS, N1PAD, F.G, (int)blockIdx.x, DM);
        pg8::EpiProj E{(pg8::bf16_t*)(ws + WS_UG), (pg8::bf16_t*)(ws + WS_Z), (pg8::bf16_t*)(ws + WS_XBC), (float*)(ws + WS_DT), MROWS};
        pg8::gemm_phase<pg8::EpiProj, pg8::StaticOrder, false, true>(F.lds, g, S, E);
        {
            constexpr int NB1 = ((MROWS / 256) * (N1PAD / 256)) % 256;
            if (F.G == 256) { if ((int)blockIdx.x >= NB1) p1_kj(F, args, ((int)blockIdx.x - NB1) * NWAVES + F.wave, (256 - NB1) * NWAVES); }
            else p1_kj(F, args, F.vcu * NWAVES + F.wave, F.G * NWAVES);
        }
        convert_fill(F, args, (MROWS / 256) * (N1PAD / 256), 1, 0, CV_GL); convert_fill(F, args, (MROWS / 256) * (N1PAD / 256), 2, 0, CV_OUT); if (!(args.pad & 2048)) convert_fill(F, args, (MROWS / 256) * (N1PAD / 256), 3, 0, CV_UP_P1);
    } SEAM(1);
    if (IN(2)) {
        const int msk = args.pad ? args.pad : 15;
        if (msk & 1) for (int u = (int)blockIdx.x * NWAVES + F.wave; u < 8192; u += F.G * NWAVES) conv_wave_item(F, args, u);
        if (msk & 1) for (int u = (int)blockIdx.x * NWAVES + F.wave; u < 2048; u += F.G * NWAVES) dt_wave_item(F, args, u);
        __syncthreads();
        if (msk & 2) for (int u = blockIdx.x; u < 256; u += F.G) s5_unit(F, args, u);
        xcd_barrier(bar);
        if (msk & 4) for (int u = blockIdx.x; u < 256; u += F.G) ssd_prompt_unit(F, args, u);
        if (msk & 8) ssd_sample_units(F, args);
    } SEAM(2);
    if (IN(3)) {
        pg8::Gemm g{(const pg8::bf16_t*)(ws + WS_G), (const pg8::bf16_t*)(ws + WS_WGLU), MROWS, 2048, 2048}; pg8::StaticOrder S; S.init(MROWS, 2048, F.G, (int)blockIdx.x, 2048);
        pg8::EpiGlu E{(const pg8::bf16_t*)(ws + WS_G), args.in[I_BGLU], (pg8::bf16_t*)(ws + WS_MIX)};
        pg8::gemm_phase<pg8::EpiGlu, pg8::StaticOrder, false, true>(F.lds, g, S, E);
        convert_fill(F, args, (MROWS / 256) * (2048 / 256), 3, CV_UP_P1, CV_UP_P1 + CV_UP_TAIL);
        {
            constexpr int NB = ((MROWS / 256) * (2048 / 256)) % 256;
            if (F.G == 256) { if ((int)blockIdx.x >= NB) p3_ssd_norm(F, args, ((int)blockIdx.x - NB) * NWAVES + F.wave, (256 - NB) * NWAVES); }
            else p3_ssd_norm(F, args, F.vcu * NWAVES + F.wave, F.G * NWAVES);
        }
    } SEAM(3);
    if (IN(4)) {
        pg8::Gemm g{(const pg8::bf16_t*)(ws + WS_MIX), (const pg8::bf16_t*)(ws + WS_WOUT), MROWS, DM, DM}; pg8::TailSplitOrder S; S.init(MROWS, MP, DM, F.G, (int)blockIdx.x, DM);
        pg8::EpiSplit<pg8::EpiStoreBf16> E{pg8::EpiStoreBf16{(pg8::bf16_t*)(ws + WS_MIXO), DM}, (float*)(ws + WS_PART)};
        pg8::gemm_phase<pg8::EpiSplit<pg8::EpiStoreBf16>, pg8::TailSplitOrder, false, true>(F.lds, g, S, E);
    } SEAM(4);
    if (IN(5)) { p5_rows(F, args); } SEAM(5);

    if (IN(6)) {
        pg8::Gemm g{(const pg8::bf16_t*)(ws + WS_HN), (const pg8::bf16_t*)(ws + WS_WUP), MROWS, N_UP, DM}; pg8::StaticOrder S; S.init(MROWS, N_UP, F.G, (int)blockIdx.x, DM);
        pg8::EpiUp E{(pg8::bf16_t*)(ws + WS_UP), args.out + O_PFFN, args.out + O_SFFN};
        pg8::gemm_phase<pg8::EpiUp, pg8::StaticOrder, false, true>(F.lds, g, S, E);
        convert_fill(F, args, (MROWS / 256) * (N_UP / 256), 4, 0, CV_DN);
    } SEAM(6);
    if (IN(7)) { p7_conv_geglu(F, args); } SEAM(7);
    if (IN(8)) {
        pg8::Gemm g{(const pg8::bf16_t*)(ws + WS_ACT), (const pg8::bf16_t*)(ws + WS_WDN), MROWS, DM, D_FF}; pg8::TailSplitOrder S; S.init(MROWS, MP, DM, F.G, (int)blockIdx.x, D_FF);
        pg8::EpiSplit<pg8::EpiStoreBf16> E{pg8::EpiStoreBf16{(pg8::bf16_t*)(ws + WS_FF), DM}, (float*)(ws + WS_PART)};
        pg8::gemm_phase<pg8::EpiSplit<pg8::EpiStoreBf16>, pg8::TailSplitOrder, false, true>(F.lds, g, S, E);
    } SEAM(8);
    if (IN(9)) { p9_rows(F, args); }
#ifdef MK_PROBE_GEMM
    if (IN(10)) {
        pg8::Gemm g{(const pg8::bf16_t*)(ws + WS_HN), (const pg8::bf16_t*)(ws + WS_WUP), MROWS, N_UP, DM}; pg8::SameTileOrder S; S.s.init(MROWS, N_UP, F.G, (int)blockIdx.x, DM);
        pg8::EpiStoreBf16 E{(pg8::bf16_t*)(ws + WS_ACT), N_UP};
        pg8::gemm_phase<pg8::EpiStoreBf16, pg8::SameTileOrder, true, true>(F.lds, g, S, E);
    }
#endif
#undef IN
#undef SEAM
}

extern "C" void kernel_launch(void* const* d_in, const int* in_sizes, int n_in, void* d_out, int out_size, void* d_ws, size_t ws_size, hipStream_t stream) {
    static int grid = 0;
    if (grid == 0) {
        if (n_in != 33 || (size_t)out_size != O_END || ws_size < WS_END) { fprintf(stderr, "kernel_launch: unexpected shapes: n_in %d out %d ws %zu (need %zu); nothing launched\n", n_in, out_size, ws_size, (size_t)WS_END); grid = -1; return; }
        int dev = 0, cus = 0, per_cu = 0;
        if (hipGetDevice(&dev) != hipSuccess || hipDeviceGetAttribute(&cus, hipDeviceAttributeMultiprocessorCount, dev) != hipSuccess) { grid = -1; return; }
        if (hipFuncSetAttribute((const void*)mk_fwd, hipFuncAttributeMaxDynamicSharedMemorySize, LDS_BYTES) != hipSuccess) { fprintf(stderr, "kernel_launch: hipFuncSetAttribute failed\n"); grid = -1; return; }
        if (hipOccupancyMaxActiveBlocksPerMultiprocessor(&per_cu, (const void*)mk_fwd, NWAVES * 64, LDS_BYTES) != hipSuccess || per_cu < 1) { fprintf(stderr, "kernel_launch: occupancy query says %d blocks per CU\n", per_cu); per_cu = 1; }
        (void)hipGetLastError();
        grid = cus;
    }
    if (grid < 0) return;
    if (hipMemsetAsync((char*)d_ws + WS_CTL, 0, CTL_ZERO_BYTES, stream) != hipSuccess) return;
    Args a{};
    for (int i = 0; i < 33; ++i) a.in[i] = (const float*)d_in[i];
    a.out = (float*)d_out; a.ws = (unsigned char*)d_ws;
#ifndef MK_LAUNCHES
#define MK_LAUNCHES {0, MK_PH_HI, 0}
#endif
    {
        const int ex[][3] = { MK_LAUNCHES };
        for (int e = 0; e < (int)(sizeof(ex) / sizeof(ex[0])); ++e) { a.ph_lo = ex[e][0]; a.ph_hi = ex[e][1]; a.bli = e; a.pad = ex[e][2]; hipLaunchKernelGGL(mk_fwd, dim3(grid), dim3(NWAVES * 64), LDS_BYTES, stream, a); }
    }
    const hipError_t le = hipPeekAtLastError();
    if (le != hipSuccess) fprintf(stderr, "kernel_launch: launch failed: %s\n", hipGetErrorName(le));
}
```

```cpp
#include <hip/hip_runtime.h>
#include <cstdio>
#include <cstdint>

namespace pg8 {
#define PG8_LAS __attribute__((address_space(3)))
typedef unsigned short bf16_t;
typedef short bf16x8 __attribute__((ext_vector_type(8)));
typedef float f32x4 __attribute__((ext_vector_type(4)));
typedef unsigned u32x4 __attribute__((ext_vector_type(4)));
constexpr int BM = 256, BK = 64, HALF = 128, HTB = HALF * BK * 2  , STAGE_BYTES = 8 * HTB, NXCD = 8, WGM = 8;

__host__ __device__ __forceinline__ int lds_byte(int r, int c) { const int st = (r >> 4) * 2 + (c >> 5), rr = r & 15, cc = c & 31, ob = rr * 64 + cc * 2; return st * 1024 + (ob ^ (((ob >> 9) & 1) << 5)); }
__host__ __device__ __forceinline__ void stage_rc(int b, int& R, int& C) { const int st = b / 1024, sb = b % 1024, swz = sb ^ (((sb >> 9) & 1) << 5); R = (st >> 1) * 16 + swz / 64; C = (st & 1) * 32 + (swz % 64) / 2; }
__host__ __device__ __forceinline__ int perm32(int rho) { const int n = rho >> 4, i = rho & 15; return 8 * (i >> 2) + 4 * n + (i & 3); }

struct Unit { int pm, pn, kk;
    __host__ __device__ __forceinline__ int k0() const { return kk & 1023; }
    __host__ __device__ __forceinline__ int nk() const { return (kk >> 10) & 1023; }
    __host__ __device__ __forceinline__ int part() const { return (kk >> 20) - 1; }
    __host__ __device__ __forceinline__ void set(int k0_, int nk_, int part_) { kk = k0_ | (nk_ << 10) | ((part_ + 1) << 20); } };
struct Gemm { const bf16_t* A; const bf16_t* Bt; int M, N, K; };

struct StaticOrder {
    int nM, nN, nwg, G, c, ntk;
    __host__ __device__ __forceinline__ void init(int M, int N, int G_, int c_, int K_) { nM = M / BM; nN = N / BM; nwg = nM * nN; G = G_; c = c_; ntk = K_ / BK; }
    __host__ __device__ __forceinline__ bool next(int i, Unit& u) const {
        const long L = (long)i * G + c; const bool ok = L < nwg;
        int wgid = ok ? (int)L : 0; { const int q = nwg / NXCD, r = nwg % NXCD, xcd = wgid % NXCD, off = wgid / NXCD; wgid = (xcd < r ? xcd * (q + 1) : r * (q + 1) + (xcd - r) * q) + off; }
        const int nig = WGM * nN, gid = wgid / nig, fm = gid * WGM, gsz = (nM - fm) < WGM ? (nM - fm) : WGM;
        u.pm = fm + ((wgid % nig) % gsz); u.pn = (wgid % nig) / gsz; u.set(0, ntk, -1); return ok;
    }
    __device__ __forceinline__ void a_ready(const Unit&) const {}
    __device__ __forceinline__ void done(const Unit&) const {}
};


struct TailSplitOrder {
    StaticOrder full; int nfull_rounds, tpm, tpn, tkk; bool split;
    __host__ __device__ __forceinline__ void init(int M, int Mfull, int N, int G_, int c_, int K_) {
        const int ntk = K_ / BK, nN = N / BM, pm0 = Mfull / BM, ntail = (M - Mfull) / BM * nN;
        split = (ntail * 4 == G_) && (((Mfull / BM) * nN) % G_ == 0) && (ntk % 8 == 0 || ntk % 8 == 4);
        if (split) { full.init(Mfull, N, G_, c_, K_); nfull_rounds = (Mfull / BM) * nN / G_; } else { full.init(M, N, G_, c_, K_); nfull_rounds = 1 << 30; }
        const int j = c_ >> 2, qd = c_ & 3, base = (ntk / 4) & ~1, extra = (ntk - 4 * base) / 2;
        Unit s; s.set(qd * base + 2 * (qd < extra ? qd : extra), base + (qd < extra ? 2 : 0), qd * ntail + j); tpm = pm0 + j / nN; tpn = j % nN; tkk = s.kk;
    }
    __host__ __device__ __forceinline__ bool next(int i, Unit& u) const {
        const bool isfull = i < nfull_rounds; Unit t; const bool okf = full.next(isfull ? i : 0, t);
        u.pm = isfull ? t.pm : tpm; u.pn = isfull ? t.pn : tpn; u.kk = isfull ? t.kk : tkk;
        return isfull ? okf : (i == nfull_rounds);
    }
    __device__ __forceinline__ void a_ready(const Unit&) const {}
    __device__ __forceinline__ void done(const Unit&) const {}
};

struct SameTileOrder {
    StaticOrder s;
    __host__ __device__ __forceinline__ bool next(int i, Unit& u) const { Unit t; const bool ok = s.next(i, t); u.pm = 0; u.pn = 0; u.kk = t.kk; return ok; }
    __device__ __forceinline__ void a_ready(const Unit&) const {}
    __device__ __forceinline__ void done(const Unit&) const {}
};

__device__ __forceinline__ unsigned cvt_pk_bf16(float lo, float hi) { unsigned r; asm volatile("v_cvt_pk_bf16_f32 %0, %1, %2" : "=v"(r) : "v"(lo), "v"(hi)); return r; }
__device__ __forceinline__ u32x4 pack8(const f32x4 v0, const f32x4 v1) { u32x4 w; w.x = cvt_pk_bf16(v0[0], v0[1]); w.y = cvt_pk_bf16(v0[2], v0[3]); w.z = cvt_pk_bf16(v1[0], v1[1]); w.w = cvt_pk_bf16(v1[2], v1[3]); return w; }
__device__ __forceinline__ float bf_lo(unsigned w) { return __uint_as_float(w << 16); }
__device__ __forceinline__ float bf_hi(unsigned w) { return __uint_as_float(w & 0xffff0000u); }

struct EpiStoreBf16 {
    static constexpr bool PERM = true, AFTER_DRAIN = false;
    bf16_t* O; int ldc;
    __device__ __forceinline__ void operator()(const f32x4 (&acc)[2][2][4][2], const Unit& u, int wr, int wc, int fr, int fq) const {
        const int row0 = u.pm * BM + wr * 64 + fr, col0 = u.pn * BM + wc * 32 + 8 * fq;
#pragma unroll
        for (int ai = 0; ai < 2; ++ai)
#pragma unroll
            for (int m = 0; m < 4; ++m) { bf16_t* rowp = O + (size_t)(row0 + ai * HALF + m * 16) * ldc + col0;
#pragma unroll
                for (int bj = 0; bj < 2; ++bj) *(u32x4*)(rowp + bj * HALF) = pack8(acc[ai][bj][m][0], acc[ai][bj][m][1]); }
    }
};
struct EpiProj {
    static constexpr bool PERM = true, AFTER_DRAIN = false;
    bf16_t* UG; bf16_t* Z; bf16_t* XBC; float* DT; int Mrows;
    __device__ __forceinline__ void operator()(const f32x4 (&acc)[2][2][4][2], const Unit& u, int wr, int wc, int fr, int fq) const {
        const int row0 = u.pm * BM + wr * 64 + fr, cl = wc * 32 + 8 * fq;
        if (u.pn < 8) {
#pragma unroll
            for (int ai = 0; ai < 2; ++ai)
#pragma unroll
                for (int m = 0; m < 4; ++m) { const int row = row0 + ai * HALF + m * 16;
#pragma unroll
                    for (int bj = 0; bj < 2; ++bj) { const int col = u.pn * BM + bj * HALF + cl; const int g = col >> 4, h0 = col & 15;
                        *(u32x4*)(UG + ((size_t)g * Mrows + row) * 16 + h0) = pack8(acc[ai][bj][m][0], acc[ai][bj][m][1]); } }
        } else if (u.pn < 32) {
            bf16_t* base = u.pn < 16 ? Z : XBC; const int ldc = u.pn < 16 ? 2048 : 4096; const int colt = (u.pn < 16 ? (u.pn - 8) : (u.pn - 16)) * BM + cl;
#pragma unroll
            for (int ai = 0; ai < 2; ++ai)
#pragma unroll
                for (int m = 0; m < 4; ++m) { bf16_t* rowp = base + (size_t)(row0 + ai * HALF + m * 16) * ldc + colt;
#pragma unroll
                    for (int bj = 0; bj < 2; ++bj) *(u32x4*)(rowp + bj * HALF) = pack8(acc[ai][bj][m][0], acc[ai][bj][m][1]); }
        } else {
            if (wc == 0) {
#pragma unroll
                for (int ai = 0; ai < 2; ++ai)
#pragma unroll
                    for (int m = 0; m < 4; ++m) { float* rowp = DT + (size_t)(row0 + ai * HALF + m * 16) * 32 + 8 * fq;
                        *(f32x4*)(rowp) = acc[ai][0][m][0]; *(f32x4*)(rowp + 4) = acc[ai][0][m][1]; }
            }
        }
    }
};
struct EpiGlu {
    static constexpr bool PERM = true, AFTER_DRAIN = false;
    const bf16_t* G; const float* bias; bf16_t* MIX;
    __device__ __forceinline__ void operator()(const f32x4 (&acc)[2][2][4][2], const Unit& u, int wr, int wc, int fr, int fq) const {
        const int row0 = u.pm * BM + wr * 64 + fr, col0 = u.pn * BM + wc * 32 + 8 * fq;
        f32x4 bv[2][2];
#pragma unroll
        for (int bj = 0; bj < 2; ++bj)
#pragma unroll
            for (int n = 0; n < 2; ++n) bv[bj][n] = *(const f32x4*)(bias + col0 + bj * HALF + 4 * n);
#pragma unroll
        for (int ai = 0; ai < 2; ++ai)
#pragma unroll
            for (int m = 0; m < 4; ++m) { const size_t row = (size_t)(row0 + ai * HALF + m * 16);
#pragma unroll
                for (int bj = 0; bj < 2; ++bj) { const int col = col0 + bj * HALF;
                    const u32x4 gw = *(const u32x4*)(G + row * 2048 + col);
                    f32x4 v0 = acc[ai][bj][m][0] + bv[bj][0], v1 = acc[ai][bj][m][1] + bv[bj][1];
                    f32x4 g0 = (f32x4){bf_lo(gw.x), bf_hi(gw.x), bf_lo(gw.y), bf_hi(gw.y)}, g1 = (f32x4){bf_lo(gw.z), bf_hi(gw.z), bf_lo(gw.w), bf_hi(gw.w)};
#pragma unroll
                    for (int j = 0; j < 4; ++j) { v0[j] = g0[j] * __builtin_amdgcn_rcpf(1.0f + __expf(-v0[j])); v1[j] = g1[j] * __builtin_amdgcn_rcpf(1.0f + __expf(-v1[j])); }
                    *(u32x4*)(MIX + row * 4096 + col) = pack8(v0, v1); } }
    }
};
struct EpiUp {
    static constexpr bool PERM = true, AFTER_DRAIN = false;
    bf16_t* UP; float* pffn; float* sffn;
    __device__ __forceinline__ void operator()(const f32x4 (&acc)[2][2][4][2], const Unit& u, int wr, int wc, int fr, int fq) const {
        const int row0 = u.pm * BM + wr * 64 + fr, col0 = u.pn * BM + wc * 32 + 8 * fq;
#pragma unroll
        for (int ai = 0; ai < 2; ++ai)
#pragma unroll
            for (int m = 0; m < 4; ++m) { const int row = row0 + ai * HALF + m * 16; bf16_t* rowp = UP + (size_t)row * 22016 + col0;
                float* st = nullptr;
                if (row < 8192) { const int t = row & 2047; if (t >= 2046) st = pffn + (size_t)((row >> 11) * 2 + (t - 2046)) * 22016; }
                else { const int r2 = row - 8192, t = r2 & 7; if (t >= 6) st = sffn + (size_t)((r2 >> 3) * 2 + (t - 6)) * 22016; }
#pragma unroll
                for (int bj = 0; bj < 2; ++bj) { *(u32x4*)(rowp + bj * HALF) = pack8(acc[ai][bj][m][0], acc[ai][bj][m][1]);
                    if (st) { *(f32x4*)(st + col0 + bj * HALF) = acc[ai][bj][m][0]; *(f32x4*)(st + col0 + bj * HALF + 4) = acc[ai][bj][m][1]; } } }
    }
};

template <class Inner> struct EpiSplit {
    static constexpr bool PERM = Inner::PERM, AFTER_DRAIN = false;
    Inner inner; float* PART;
    __device__ __forceinline__ void operator()(const f32x4 (&acc)[2][2][4][2], const Unit& u, int wr, int wc, int fr, int fq) const {
        if (u.part() < 0) { inner(acc, u, wr, wc, fr, fq); return; }
        static_assert(Inner::PERM, "EpiSplit assumes the PERM = true layout");
        bf16_t* base = (bf16_t*)PART + (size_t)u.part() * 65536 + (size_t)(wr * 64 + fr) * 256 + wc * 32 + 8 * fq;
#pragma unroll
        for (int ai = 0; ai < 2; ++ai)
#pragma unroll
            for (int m = 0; m < 4; ++m) { bf16_t* rowp = base + (size_t)(ai * HALF + m * 16) * 256;
#pragma unroll
                for (int bj = 0; bj < 2; ++bj) *(u32x4*)(rowp + bj * HALF) = pack8(acc[ai][bj][m][0], acc[ai][bj][m][1]); }
    }
};
template <class Epi, class Sched, bool ALIGN_EPI = false, bool SP2 = false>
__device__ __forceinline__ void gemm_phase(PG8_LAS unsigned char* lds, const Gemm g, const Sched& S, const Epi& E) {
    const int tid = threadIdx.x, wid = __builtin_amdgcn_readfirstlane(tid >> 6), lane = tid & 63, wr = wid >> 2, wc = wid & 3, fr = lane & 15, fq = lane >> 4;
    const int K = g.K;
    unsigned voffA[2], voffB[2];
#pragma unroll
    for (int i = 0; i < 2; ++i) { int R, C; stage_rc(tid * 16 + i * 8192, R, C); const int Rb = Epi::PERM ? ((R & ~31) + perm32(R & 31)) : R;
        voffA[i] = (unsigned)(R * K + C) * 2u; voffB[i] = (unsigned)(Rb * K + C) * 2u; }
    const size_t kstep = (size_t)(BK * 2);
    const size_t hstep = (size_t)HALF * K * 2;
    const size_t tstep = 2 * hstep;
    const unsigned ldsw = (unsigned)wid * 1024u;
    const int aoff = lds_byte(wr * 64 + fr, fq * 8), boff = lds_byte(wc * 32 + fr, fq * 8);
#define PG8_SA(b, h) (((b) * 2 + (h)) * HTB)
#define PG8_SB(b, h) ((4 + (b) * 2 + (h)) * HTB)
#define PG8_STAGE(bufoff, gbase, voff) do { _Pragma("unroll") for (int _i = 0; _i < 2; ++_i) \
        __builtin_amdgcn_global_load_lds((const unsigned*)((const char*)(gbase) + (voff)[_i]), (PG8_LAS unsigned*)(lds + (bufoff) + ldsw + _i * 8192), 16, 0, 0); } while (0)
#define PG8_LDA(dst, b, h) do { _Pragma("unroll") for (int m = 0; m < 4; ++m) _Pragma("unroll") for (int k = 0; k < 2; ++k) dst[m][k] = *(const PG8_LAS bf16x8*)(lds + PG8_SA(b, h) + aoff + m * 2048 + k * 1024); } while (0)
#define PG8_LDB(dst, b, h) do { _Pragma("unroll") for (int n = 0; n < 2; ++n) _Pragma("unroll") for (int k = 0; k < 2; ++k) dst[n][k] = *(const PG8_LAS bf16x8*)(lds + PG8_SB(b, h) + boff + n * 2048 + k * 1024); } while (0)
#define PG8_MMA(ai, bj, At, Bt) do { __builtin_amdgcn_s_setprio(1); _Pragma("unroll") for (int m = 0; m < 4; ++m) _Pragma("unroll") for (int n = 0; n < 2; ++n) _Pragma("unroll") for (int k = 0; k < 2; ++k) \
        acc[ai][bj][m][n] = __builtin_amdgcn_mfma_f32_16x16x32_bf16(Bt[n][k], At[m][k], acc[ai][bj][m][n], 0, 0, 0); __builtin_amdgcn_s_setprio(0); } while (0)
#define PG8_WAIT_V(n) asm volatile("s_waitcnt vmcnt(" #n ")" ::: "memory")
#define PG8_WAIT_L(n) asm volatile("s_waitcnt lgkmcnt(" #n ")" ::: "memory")
#define PG8_BAR __builtin_amdgcn_s_barrier()
#define PG8_SCHED __builtin_amdgcn_sched_barrier(0)
    Unit cur, nxt; int ui = 0;
    if (!S.next(0, cur)) return;
    f32x4 acc[2][2][4][2];
#pragma unroll
    for (int a = 0; a < 2; ++a)
#pragma unroll
        for (int b = 0; b < 2; ++b)
#pragma unroll
            for (int m = 0; m < 4; ++m)
#pragma unroll
                for (int n = 0; n < 2; ++n) acc[a][b][m][n] = (f32x4){0.f, 0.f, 0.f, 0.f};
    bf16x8 At[4][2], B0[2][2], B1[2][2];
    const char* cA = (const char*)g.A + (size_t)cur.pm * tstep + (size_t)cur.k0() * kstep; const char* cB = (const char*)g.Bt + (size_t)cur.pn * tstep + (size_t)cur.k0() * kstep;
    int nt = cur.nk();
    S.a_ready(cur);
    if constexpr (SP2) {
        PG8_STAGE(PG8_SB(0, 0), cB, voffB); PG8_STAGE(PG8_SB(0, 1), cB + hstep, voffB); PG8_STAGE(PG8_SA(0, 0), cA, voffA); PG8_STAGE(PG8_SA(0, 1), cA + hstep, voffA);
        if (wr == 1) PG8_BAR;
        PG8_WAIT_V(2); PG8_BAR;
        PG8_STAGE(PG8_SB(1, 0), cB + kstep, voffB); PG8_STAGE(PG8_SA(1, 0), cA + kstep, voffA); PG8_STAGE(PG8_SB(1, 1), cB + hstep + kstep, voffB);
        PG8_WAIT_V(6); PG8_BAR;
    } else {
        PG8_STAGE(PG8_SB(0, 0), cB, voffB); PG8_STAGE(PG8_SA(0, 0), cA, voffA); PG8_STAGE(PG8_SB(0, 1), cB + hstep, voffB); PG8_STAGE(PG8_SA(0, 1), cA + hstep, voffA);
        if (wr == 1) PG8_BAR;
        PG8_WAIT_V(4); PG8_BAR;
        PG8_STAGE(PG8_SB(1, 0), cB + kstep, voffB); PG8_STAGE(PG8_SA(1, 0), cA + kstep, voffA); PG8_STAGE(PG8_SB(1, 1), cB + hstep + kstep, voffB);
        PG8_WAIT_V(6); PG8_BAR;
    }
    for (;;) {
        const bool has_next = S.next(ui + 1, nxt);
        const char* nA = has_next ? (const char*)g.A + (size_t)nxt.pm * tstep + (size_t)nxt.k0() * kstep : cA; const char* nB = has_next ? (const char*)g.Bt + (size_t)nxt.pn * tstep + (size_t)nxt.k0() * kstep : cB;
        for (int t = 0; t < nt; t += 2) {
            const bool last = (t == nt - 2);
            const char* a1 = cA + (size_t)(t + 1) * kstep;
            const char* a2 = last ? nA : cA + (size_t)(t + 2) * kstep; const char* b2 = last ? nB : cB + (size_t)(t + 2) * kstep;
            const char* a3 = a2 + kstep; const char* b3 = b2 + kstep;
            if (last && has_next) S.a_ready(nxt);
            if constexpr (SP2) {
            PG8_LDB(B0, 0, 0); PG8_LDB(B1, 0, 1); PG8_SCHED; PG8_LDA(At, 0, 0); PG8_STAGE(PG8_SA(1, 1), a1 + hstep, voffA);
            PG8_WAIT_V(8); PG8_WAIT_L(0); PG8_BAR; PG8_MMA(0, 0, At, B0); PG8_MMA(0, 1, At, B1); PG8_BAR; PG8_SCHED;
            PG8_LDA(At, 0, 1); PG8_STAGE(PG8_SB(0, 0), b2, voffB); PG8_STAGE(PG8_SB(0, 1), b2 + hstep, voffB); PG8_STAGE(PG8_SA(0, 0), a2, voffA);
            PG8_WAIT_V(8); PG8_WAIT_L(0); PG8_BAR; PG8_MMA(1, 0, At, B0); PG8_MMA(1, 1, At, B1); PG8_BAR; PG8_SCHED;
            PG8_LDB(B0, 1, 0); PG8_LDB(B1, 1, 1); PG8_SCHED; PG8_LDA(At, 1, 0); PG8_STAGE(PG8_SA(0, 1), a2 + hstep, voffA);
            PG8_WAIT_V(8); PG8_WAIT_L(0); PG8_BAR; PG8_MMA(0, 0, At, B0); PG8_MMA(0, 1, At, B1); PG8_BAR; PG8_SCHED;
            PG8_LDA(At, 1, 1); PG8_STAGE(PG8_SB(1, 0), b3, voffB); PG8_STAGE(PG8_SB(1, 1), b3 + hstep, voffB); PG8_STAGE(PG8_SA(1, 0), a3, voffA);
            PG8_WAIT_V(8); PG8_WAIT_L(0); PG8_BAR; PG8_MMA(1, 0, At, B0); PG8_MMA(1, 1, At, B1); PG8_BAR; PG8_SCHED;
            } else {
            PG8_LDB(B0, 0, 0); PG8_SCHED; PG8_LDA(At, 0, 0); PG8_STAGE(PG8_SA(1, 1), a1 + hstep, voffA);
            PG8_WAIT_L(8); PG8_BAR; PG8_WAIT_L(0); PG8_MMA(0, 0, At, B0); PG8_BAR; PG8_SCHED;
            PG8_LDB(B1, 0, 1); PG8_STAGE(PG8_SB(0, 0), b2, voffB);
            PG8_BAR; PG8_WAIT_L(0); PG8_MMA(0, 1, At, B1); PG8_BAR;
            PG8_LDA(At, 0, 1); PG8_STAGE(PG8_SA(0, 0), a2, voffA);
            PG8_BAR; PG8_WAIT_L(0); PG8_MMA(1, 0, At, B0); PG8_BAR; PG8_SCHED;
            PG8_STAGE(PG8_SB(0, 1), b2 + hstep, voffB);
            PG8_WAIT_V(6); PG8_BAR; PG8_MMA(1, 1, At, B1); PG8_BAR;
            PG8_LDB(B0, 1, 0); PG8_SCHED; PG8_LDA(At, 1, 0); PG8_STAGE(PG8_SA(0, 1), a2 + hstep, voffA);
            PG8_WAIT_L(8); PG8_BAR; PG8_WAIT_L(0); PG8_MMA(0, 0, At, B0); PG8_BAR; PG8_SCHED;
            PG8_LDB(B1, 1, 1); PG8_STAGE(PG8_SB(1, 0), b3, voffB);
            PG8_BAR; PG8_WAIT_L(0); PG8_MMA(0, 1, At, B1); PG8_BAR;
            PG8_LDA(At, 1, 1); PG8_STAGE(PG8_SA(1, 0), a3, voffA);
            PG8_BAR; PG8_WAIT_L(0); PG8_MMA(1, 0, At, B0); PG8_BAR; PG8_SCHED;
            PG8_STAGE(PG8_SB(1, 1), b3 + hstep, voffB);
            PG8_WAIT_V(6); PG8_BAR; PG8_MMA(1, 1, At, B1); PG8_BAR;
            }
        }
        if constexpr (ALIGN_EPI) { if (wr == 0) PG8_BAR; }
        if constexpr (!Epi::AFTER_DRAIN) { E(acc, cur, wr, wc, fr, fq); S.done(cur); }
        if (!has_next) break;
#pragma unroll
        for (int a = 0; a < 2; ++a)
#pragma unroll
            for (int b = 0; b < 2; ++b)
#pragma unroll
                for (int m = 0; m < 4; ++m)
#pragma unroll
                    for (int n = 0; n < 2; ++n) acc[a][b][m][n] = (f32x4){0.f, 0.f, 0.f, 0.f};
        cur = nxt; cA = nA; cB = nB; ++ui; nt = cur.nk();
        if constexpr (ALIGN_EPI) { if (wr == 1) PG8_BAR; }
    }
    PG8_WAIT_V(0);
    if constexpr (!ALIGN_EPI) { if (wr == 0) PG8_BAR; }
    PG8_BAR;
    if constexpr (Epi::AFTER_DRAIN) { E.fused(acc, cur, wr, wc, fr, fq, lds, wid, lane); S.done(cur); }
#undef PG8_SA
#undef PG8_SB
#undef PG8_STAGE
#undef PG8_LDA
#undef PG8_LDB
#undef PG8_MMA
#undef PG8_WAIT_V
#undef PG8_WAIT_L
#undef PG8_BAR
#undef PG8_SCHED
}
}
#define GAS __attribute__((address_space(1)))
#define LAS __attribute__((address_space(3)))
typedef unsigned short bf16;
typedef unsigned v4u __attribute__((ext_vector_type(4)));
typedef float f32x4 __attribute__((ext_vector_type(4)));
typedef short bf16x8 __attribute__((ext_vector_type(8)));
typedef GAS unsigned gu32;
typedef GAS unsigned long long gu64;
#define RLX_AGENT __ATOMIC_RELAXED, __HIP_MEMORY_SCOPE_AGENT
#define LDS_WAIT() asm volatile("s_waitcnt lgkmcnt(0)" ::: "memory")
#define VM_WAIT() asm volatile("s_waitcnt vmcnt(0)" ::: "memory")
__device__ __forceinline__ unsigned long long rt() { return __builtin_amdgcn_s_memrealtime(); }
__device__ __forceinline__ unsigned f2bf(float f) { unsigned u = __builtin_bit_cast(unsigned, f); return (u + 0x7fffu + ((u >> 16) & 1u)) >> 16; }
typedef float f32x2_t __attribute__((ext_vector_type(2)));
typedef __bf16 bf16x2_t __attribute__((ext_vector_type(2)));
__device__ __forceinline__ unsigned pk2(float lo, float hi) { const f32x2_t v = {lo, hi}; return __builtin_bit_cast(unsigned, __builtin_convertvector(v, bf16x2_t)); }

#define XB_TMO      128
#define XB_XCNT(j)  (256  + 64 * (j))
#define XB_XSUB(j)  (1280 + 64 * (j))
#define XB_XGEN(j)  (2304 + 64 * (j))
#define XB_TOP      3328
#define XB_TOPGEN   3392
#define XCD_BAR_WORDS 3456
#define XB_SPIN_CAP (1u << 18)

__device__ __forceinline__ unsigned xb_ld(unsigned* p)              { return __hip_atomic_load(p, __ATOMIC_RELAXED, __HIP_MEMORY_SCOPE_AGENT); }
__device__ __forceinline__ unsigned xb_add(unsigned* p, unsigned v) { return __hip_atomic_fetch_add(p, v, __ATOMIC_RELAXED, __HIP_MEMORY_SCOPE_AGENT); }
__device__ __forceinline__ unsigned xb_xcc_id() { return (unsigned)__builtin_amdgcn_s_getreg((3 << 11) | 20) & 0xFu; }
#define XB_SPIN(cond, bar) do { unsigned _sp = 0; while (cond) { __builtin_amdgcn_s_sleep(1); \
    if ((++_sp & 255u) == 0u) { if (xb_ld(&(bar)[XB_TMO])) break; if (_sp > XB_SPIN_CAP) { atomicAdd(&(bar)[XB_TMO], 1u); break; } } } } while (0)

struct XcdBarrier {
    unsigned* bar; unsigned x;
    volatile LAS unsigned* st;
};

__device__ __forceinline__ XcdBarrier xcd_barrier_post(unsigned* bar, volatile LAS unsigned* st) {
    XcdBarrier b; b.bar = bar; b.x = xb_xcc_id(); b.st = st;
    if (threadIdx.x == 0) (void)xb_add(&bar[XB_XCNT(b.x)], 1u);
    return b;
}
__device__ __forceinline__ void xcd_barrier_complete(unsigned* bar, unsigned x, unsigned& nloc, unsigned& nx) {
    const unsigned G = gridDim.x * gridDim.y * gridDim.z;
    unsigned sum, cnt, mine, sp = 0u;
    for (;;) {
        sum = 0u; cnt = 0u; mine = 0u;
#pragma unroll
        for (unsigned j = 0; j < 16; ++j) { const unsigned c = xb_ld(&bar[XB_XCNT(j)]); sum += c; cnt += (c > 0u) ? 1u : 0u; mine = (j == x) ? c : mine; }
        if (sum == G) break;
        __builtin_amdgcn_s_sleep(1);
        if ((++sp & 255u) == 0u) { if (xb_ld(&bar[XB_TMO])) break; if (sp > XB_SPIN_CAP) { atomicAdd(&bar[XB_TMO], 1u); break; } }
    }
    nloc = mine > 0u ? mine : 1u; nx = cnt > 0u ? cnt : 1u;
}

__device__ __forceinline__ void xcd_barrier(const XcdBarrier& b) {
    asm volatile("s_waitcnt vmcnt(0)" ::: "memory");
    __syncthreads();
    if (threadIdx.x == 0) {
        unsigned* bar = b.bar;
        __builtin_amdgcn_s_waitcnt(0);
        unsigned nloc = b.st[0], nx = b.st[1];
        if (nloc == 0u) { xcd_barrier_complete(bar, b.x, nloc, nx); b.st[0] = nloc; b.st[1] = nx; }
        const unsigned old = xb_add(&bar[XB_XSUB(b.x)], 1u);
        const unsigned gen = old / nloc;
        if (old + 1u == (gen + 1u) * nloc) {
            __builtin_amdgcn_fence(__ATOMIC_RELEASE, "agent");
            asm volatile("s_waitcnt vmcnt(0)" ::: "memory");
            const unsigned og = xb_add(&bar[XB_TOP], 1u);
            const unsigned tg = og / nx;
            if (og + 1u == (tg + 1u) * nx) xb_add(&bar[XB_TOPGEN], 1u);
            else XB_SPIN(xb_ld(&bar[XB_TOPGEN]) == tg, bar);
            __builtin_amdgcn_fence(__ATOMIC_ACQUIRE, "agent");
            xb_add(&bar[XB_XGEN(b.x)], 1u);
            asm volatile("s_waitcnt vmcnt(0)" ::: "memory");
        } else {
            XB_SPIN(xb_ld(&bar[XB_XGEN(b.x)]) == gen, bar);
            __builtin_amdgcn_fence(__ATOMIC_ACQUIRE, "agent");
            asm volatile("s_waitcnt vmcnt(0)" ::: "memory");
        }
    }
    __syncthreads();
}

constexpr int NWAVES = 8;
constexpr int DM = 4096, MP = 8192, MS = 1024, MROWS = 9216;
constexpr int D_IN = 8224, N1PAD = 8448, D_FF = 11008, N_UP = 22016;
constexpr float EPS = 1e-6f;
#ifndef MK_PH_HI
#define MK_PH_HI 10
#endif
#ifndef MK_N_LAUNCHES
#define MK_N_LAUNCHES 1
#endif
constexpr int N_PHASES = 10;

constexpr size_t O_Y = 0;
constexpr size_t O_PS5RE = (size_t)MROWS * DM;
constexpr size_t O_PS5IM = O_PS5RE + 4 * 128 * 64;
constexpr size_t O_PCONV = O_PS5IM + 4 * 128 * 64;
constexpr size_t O_PSSD  = O_PCONV + 4 * 3 * 4096;
constexpr size_t O_PFFN  = O_PSSD + (size_t)4 * 32 * 64 * 128;
constexpr size_t O_SS5RE = O_PFFN + 4 * 2 * 22016;
constexpr size_t O_SS5IM = O_SS5RE + 128 * 128 * 64;
constexpr size_t O_SCONV = O_SS5IM + 128 * 128 * 64;
constexpr size_t O_SSSD  = O_SCONV + 128 * 3 * 4096;
constexpr size_t O_SFFN  = O_SSSD + (size_t)128 * 32 * 64 * 128;
constexpr size_t O_END   = O_SFFN + (size_t)128 * 2 * 22016;
static_assert(O_END == 81948672, "output size");
constexpr size_t MiB = 1u << 20;
constexpr size_t WS_CTL = 0, CTL_ZERO_BYTES = 1 * MiB;
constexpr size_t WS_LAM = 1 * MiB;
constexpr size_t WS_BBR = 2 * MiB, WS_BBI = 2 * MiB + 512 * 1024;
constexpr size_t WS_KJ  = 3 * MiB;
constexpr size_t WS_DT  = 4 * MiB;
constexpr size_t WS_SSQP = 6 * MiB;
constexpr size_t WS_DTP = 8 * MiB;
constexpr size_t WS_WUP = 24 * MiB;
constexpr size_t WS_WDN = 196 * MiB;
constexpr size_t WS_HN  = 282 * MiB;
constexpr size_t WS_MIXO = 354 * MiB;
constexpr size_t WS_FF  = 426 * MiB;
constexpr size_t WS_ACT = 498 * MiB;
constexpr size_t WS_WIN = 692 * MiB;
constexpr size_t WS_WGLU = 758 * MiB;
constexpr size_t WS_WOUT = 766 * MiB;
constexpr size_t WS_UG  = 798 * MiB;
constexpr size_t WS_Z   = 834 * MiB;
constexpr size_t WS_XBC = 870 * MiB;
constexpr size_t WS_G   = 942 * MiB;
constexpr size_t WS_MIX = 978 * MiB;
constexpr size_t WS_YG  = 1050 * MiB;
constexpr size_t WS_XC  = 1082 * MiB;
constexpr size_t WS_UP  = 692 * MiB;
constexpr size_t WS_PART = 1162 * MiB;
constexpr size_t WS_X1  = 1226 * MiB;
constexpr size_t WS_END = 1298 * MiB;
static_assert(WS_UP + (size_t)MROWS * N_UP * 2 <= WS_XC && WS_ACT + (size_t)MROWS * D_FF * 2 <= WS_WIN, "ws map");
constexpr int CW_BAR = 4096;
constexpr int RING_BYTES = 131072, LDS_BYTES = 147456, MISC_OFF = LDS_BYTES - 256;

struct Frame {
    LAS unsigned char* lds;
    int tid, lane, wave, vcu, G;
};
struct Args { const float* in[33]; float* out; unsigned char* ws; int ph_lo, ph_hi, bli, pad; };
enum { I_XP = 0, I_XS, I_S5RE, I_S5IM, I_SCONV, I_SSSD, I_SFFN, I_GPRE, I_GPOST, I_GFPRE, I_GFPOST, I_WIN, I_ARE, I_AIM, I_LOGDT, I_BRE, I_BIM, I_CRE, I_CIM, I_S5D, I_WGLU, I_BGLU,
       I_CONVW, I_CONVB, I_DTB, I_ALOG, I_SSDD, I_NORMW, I_WOUT, I_WUP, I_FCW, I_FCB, I_WDN };

__device__ __forceinline__ float wave_sum(float v) {
#pragma unroll
    for (int o = 1; o < 64; o <<= 1) v += __shfl_xor(v, o);
    return v;
}
typedef unsigned v2u __attribute__((ext_vector_type(2)));
__device__ __forceinline__ bf16 f2bf1(float x) { return (bf16)pk2(x, x); }
__device__ __forceinline__ float bf2f(bf16 b) { return __uint_as_float(((unsigned)b) << 16); }
__device__ __forceinline__ void unpack8(const v4u w, float (&o)[8]) {
    o[0] = __uint_as_float(w.x << 16); o[1] = __uint_as_float(w.x & 0xffff0000u); o[2] = __uint_as_float(w.y << 16); o[3] = __uint_as_float(w.y & 0xffff0000u);
    o[4] = __uint_as_float(w.z << 16); o[5] = __uint_as_float(w.z & 0xffff0000u); o[6] = __uint_as_float(w.w << 16); o[7] = __uint_as_float(w.w & 0xffff0000u);
}
__device__ __forceinline__ v4u pack8f(const float (&o)[8]) { v4u w; w.x = pk2(o[0], o[1]); w.y = pk2(o[2], o[3]); w.z = pk2(o[4], o[5]); w.w = pk2(o[6], o[7]); return w; }
__device__ __forceinline__ float silu_f(float v) { return v * __builtin_amdgcn_rcpf(1.0f + __expf(-v)); }
__device__ __forceinline__ float gelu_tanh_f(float v) { const float t = 1.5957691216057308f * (v + 0.044715f * v * v * v); return v * __builtin_amdgcn_rcpf(1.0f + __expf(-t)); }
__device__ __forceinline__ float softplus_f(float v) { const float e = __expf(v); return v > 15.f ? v : (v < -4.f ? e * (1.0f - 0.5f * e + 0.33333334f * e * e) : __logf(1.0f + e)); }
typedef unsigned short u16x4_t __attribute__((ext_vector_type(4)));
__device__ __forceinline__ u16x4_t tr_read(unsigned lds_addr) { u16x4_t r; asm volatile("ds_read_b64_tr_b16 %0, %1\n\ts_waitcnt lgkmcnt(0)" : "=&v"(r) : "v"(lds_addr) : "memory"); return r; }
__device__ __forceinline__ bf16x8 tr_frag(unsigned img_base, int pitch, int r0, int c0, int lane) {
    const int g = lane >> 4, qq = (lane & 15) >> 2, pp = lane & 3;
    const unsigned a0 = img_base + (unsigned)(((r0 + 8 * g + qq) * pitch + c0 + 4 * pp) * 2);
    const u16x4_t lo = tr_read(a0), hi = tr_read(a0 + (unsigned)(4 * pitch * 2));
    typedef unsigned short u16x8_t __attribute__((ext_vector_type(8)));
    const u16x8_t v = {lo[0], lo[1], lo[2], lo[3], hi[0], hi[1], hi[2], hi[3]};
    return __builtin_bit_cast(bf16x8, v);
}
__device__ __forceinline__ f32x4 mfma16(bf16x8 a, bf16x8 b, f32x4 c) { return __builtin_amdgcn_mfma_f32_16x16x32_bf16(a, b, c, 0, 0, 0); }

__device__ __forceinline__ void p0_transpose_item(const float* W, int K, int N, bf16* WT, LAS float* scr, int item, int lane) {
    const int nblk = N / 32, kb = item / nblk, nb = item % nblk, k0 = 64 * kb, n0 = 32 * nb;
#pragma unroll 8
    for (int i = 0; i < 32; ++i) { const int kk = 2 * i + (lane >> 5); scr[kk * 33 + (lane & 31)] = W[(size_t)(k0 + kk) * N + n0 + (lane & 31)]; }
    LDS_WAIT(); asm volatile("" ::: "memory");
    const int c = lane & 7;
#pragma unroll
    for (int j = 0; j < 4; ++j) { const int n = (lane >> 3) + 8 * j; const LAS float* s = scr + (8 * c) * 33 + n;
        v4u o; o.x = pk2(s[0 * 33], s[1 * 33]); o.y = pk2(s[2 * 33], s[3 * 33]); o.z = pk2(s[4 * 33], s[5 * 33]); o.w = pk2(s[6 * 33], s[7 * 33]);
        *(GAS v4u*)(WT + (size_t)(n0 + n) * K + k0 + 8 * c) = o; }
    LDS_WAIT(); asm volatile("" ::: "memory");
}
__device__ __forceinline__ void gain_to_lds(LAS unsigned char* lds, int off, const float* g, int tid) {
#pragma unroll
    for (int i = 0; i < 2; ++i) *(LAS f32x4*)(lds + off + (tid + 512 * i) * 16) = ((const f32x4*)g)[tid + 512 * i];
}
__device__ __forceinline__ void rms_row_to_bf16(const float* xrow, const LAS float* gain, bf16* orow, int lane) {
    const f32x4* xr = (const f32x4*)xrow + lane; const LAS f32x4* gr = (const LAS f32x4*)gain + lane;
    f32x4 v[16]; float s = 0.f;
#pragma unroll
    for (int j = 0; j < 16; ++j) { v[j] = xr[64 * j]; s += (v[j].x * v[j].x + v[j].y * v[j].y) + (v[j].z * v[j].z + v[j].w * v[j].w); }
    const float rstd = 1.0f / sqrtf(wave_sum(s) * (1.f / DM) + EPS);
    unsigned long long* o8 = (unsigned long long*)orow + lane;
#pragma unroll
    for (int j = 0; j < 16; ++j) { const f32x4 g = gr[64 * j]; o8[64 * j] = (unsigned long long)pk2(v[j].x * rstd * g.x, v[j].y * rstd * g.y) | ((unsigned long long)pk2(v[j].z * rstd * g.z, v[j].w * rstd * g.w) << 32); }
}
constexpr int CV_IN = (DM / 64) * (D_IN / 32), CV_GL = (2048 / 64) * (2048 / 32), CV_OUT = (DM / 64) * (DM / 32), CV_UP = (DM / 64) * (N_UP / 32), CV_DN = (D_FF / 64) * (DM / 32);
constexpr int CV_UP_P1 = 8192, CV_UP_TAIL = 14336;
__device__ __forceinline__ void convert_stream(const float* W, int K, int N, bf16* WT, LAS float* scr, int lo, int hi, int worker, int nworkers, int lane) {
    const int nblk = N / 32, c = lane & 7;
    f32x4 va[8], vb[8];
#define CV_LOAD(v, item) do { const int kb_ = (item) / nblk, nb_ = (item) % nblk; const float* p_ = W + (size_t)(64 * kb_ + (lane >> 3)) * N + 32 * nb_ + 4 * (lane & 7); \
        _Pragma("unroll") for (int i = 0; i < 8; ++i) v[i] = __builtin_nontemporal_load((const f32x4*)(p_ + (size_t)(8 * i) * N)); } while (0)
#define CV_FINISH(v, item) do { const int kb_ = (item) / nblk, nb_ = (item) % nblk; \
        _Pragma("unroll") for (int i = 0; i < 8; ++i) { LAS float* w_ = scr + (8 * i + (lane >> 3)) * 33 + 4 * (lane & 7); w_[0] = v[i].x; w_[1] = v[i].y; w_[2] = v[i].z; w_[3] = v[i].w; } \
        LDS_WAIT(); asm volatile("" ::: "memory"); \
        _Pragma("unroll") for (int j = 0; j < 4; ++j) { const int n_ = (lane >> 3) + 8 * j; const LAS float* s = scr + (8 * c) * 33 + n_; \
            v4u o; o.x = pk2(s[0 * 33], s[1 * 33]); o.y = pk2(s[2 * 33], s[3 * 33]); o.z = pk2(s[4 * 33], s[5 * 33]); o.w = pk2(s[6 * 33], s[7 * 33]); \
            __builtin_nontemporal_store(o, (GAS v4u*)(WT + (size_t)(32 * nb_ + n_) * K + 64 * kb_ + 8 * c)); } \
        LDS_WAIT(); asm volatile("" ::: "memory"); } while (0)
    int it = lo + worker;
    if (it >= hi) return;
    CV_LOAD(va, it);
    for (;;) {
        const int itn = it + nworkers, itc = itn < hi ? itn : it;
        CV_LOAD(vb, itc);
        CV_FINISH(va, it);
        if (itn >= hi) break;
        const int itn2 = itn + nworkers, itc2 = itn2 < hi ? itn2 : itn;
        CV_LOAD(va, itc2);
        CV_FINISH(vb, itn);
        if (itn2 >= hi) break;
        it = itn2;
    }
#undef CV_LOAD
#undef CV_FINISH
}
__device__ __forceinline__ void convert_items(Frame& F, const Args& a, int which, int lo, int hi, int worker, int nworkers) {
    unsigned char* ws = a.ws; LAS float* scr = (LAS float*)(F.lds + F.wave * 16384);
    const float* W; int K, N; bf16* WT;
    if (which == 0) { W = a.in[I_WIN]; K = DM; N = D_IN; WT = (bf16*)(ws + WS_WIN); }
    else if (which == 1) { W = a.in[I_WGLU]; K = 2048; N = 2048; WT = (bf16*)(ws + WS_WGLU); }
    else if (which == 2) { W = a.in[I_WOUT]; K = DM; N = DM; WT = (bf16*)(ws + WS_WOUT); }
    else if (which == 3) { W = a.in[I_WUP]; K = DM; N = N_UP; WT = (bf16*)(ws + WS_WUP); }
    else { W = a.in[I_WDN]; K = D_FF; N = DM; WT = (bf16*)(ws + WS_WDN); }
    convert_stream(W, K, N, WT, scr, lo, hi, worker, nworkers, F.lane);
}
__device__ __forceinline__ void convert_fill(Frame& F, const Args& a, int nunits, int which, int lo, int hi) {
    if (F.G != 256 || (a.pad & 32)) return;
    const int nbusy = nunits % F.G; if (nbusy == 0 || (int)blockIdx.x < nbusy) return;
    convert_items(F, a, which, lo, hi, ((int)blockIdx.x - nbusy) * NWAVES + F.wave, (F.G - nbusy) * NWAVES);
}
__device__ __forceinline__ void p0_prologue(Frame& F, const Args& a) {
    unsigned char* ws = a.ws;
    LAS float* scr = (LAS float*)(F.lds + F.wave * 16384);
    const int gw = F.vcu * NWAVES + F.wave, NGW = F.G * NWAVES;
    {
        float2* LAM = (float2*)(ws + WS_LAM); float* BBR = (float*)(ws + WS_BBR); float* BBI = (float*)(ws + WS_BBI);
        for (int it = (NGW - 1 - gw) * 64 + F.lane; it < 128 * 64 * 4; it += NGW * 64) {
            const int i = it >> 2, hq = it & 3, g = i >> 6, p = i & 63;
            const float ar = a.in[I_ARE][i], ai = a.in[I_AIM][i], dt = expf(a.in[I_LOGDT][g]);
            const f32x4 br = *(const f32x4*)(a.in[I_BRE] + i * 16 + 4 * hq), bi = *(const f32x4*)(a.in[I_BIM] + i * 16 + 4 * hq);
            const float mag = expf(ar * dt), th = ai * dt;
            const float lbr = mag * cosf(th), lbi = mag * sinf(th);
            if (hq == 0) { float cr = 1.f, ci = 0.f;
#pragma unroll
                for (int j = 0; j < 9; ++j) { LAM[(g * 9 + j) * 64 + p] = make_float2(cr, ci); const float nr = cr * lbr - ci * lbi, ni = cr * lbi + ci * lbr; cr = nr; ci = ni; } }
            const float den = ar * ar + ai * ai, nr1 = lbr - 1.0f;
            const float fr = (nr1 * ar + lbi * ai) / den, fi = (lbi * ar - nr1 * ai) / den;
            *(f32x4*)(BBR + i * 16 + 4 * hq) = fr * br - fi * bi; *(f32x4*)(BBI + i * 16 + 4 * hq) = fr * bi + fi * br;
        }
    }
    const bool spread = (F.G == 256);
    if (!(a.pad & 64)) convert_items(F, a, 0, 0, CV_IN, gw, NGW);
    if (a.pad & 64) {}
    else if (spread) convert_items(F, a, 3, CV_UP_P1 + CV_UP_TAIL, CV_UP, gw, NGW);
    else { convert_items(F, a, 1, 0, CV_GL, gw, NGW); convert_items(F, a, 2, 0, CV_OUT, gw, NGW); convert_items(F, a, 3, 0, CV_UP, gw, NGW); convert_items(F, a, 4, 0, CV_DN, gw, NGW); }
    {
        v4u* z = (v4u*)(ws + WS_WIN + (size_t)D_IN * DM * 2); const int nz = (N1PAD - D_IN) * DM * 2 / 16;
        for (int i = gw * 64 + F.lane; i < nz; i += NGW * 64) z[i] = (v4u){0u, 0u, 0u, 0u};
    }
    __syncthreads();
    gain_to_lds(F.lds, 0, a.in[I_GPRE], F.tid);
    __syncthreads();
    if (!(a.pad & 128)) for (int m = gw; m < MROWS; m += NGW) {
        const float* xrow = m < MP ? a.in[I_XP] + (size_t)m * DM : a.in[I_XS] + (size_t)(m - MP) * DM;
        rms_row_to_bf16(xrow, (const LAS float*)F.lds, (bf16*)(ws + WS_HN) + (size_t)m * DM, F.lane);
    }
}
__device__ __forceinline__ void p1_kj(Frame& F, const Args& a, int gwk, int ngwk) {
    unsigned char* ws = a.ws;
    const float2* LAM = (const float2*)(ws + WS_LAM); const float* BBR = (const float*)(ws + WS_BBR); const float* BBI = (const float*)(ws + WS_BBI); float* KJ = (float*)(ws + WS_KJ);
    const int gt = gwk * 64 + F.lane, NT = ngwk * 64;
    for (int i = gt; i < 128 * 8 * 16 * 4; i += NT) {
        const int g = i >> 9, j = (i >> 6) & 7, h = (i >> 2) & 15, hp0 = 4 * (i & 3);
        f32x4 acc = (f32x4){0.f, 0.f, 0.f, 0.f};
        const f32x4* Lp = (const f32x4*)(LAM + (g * 9 + j) * 64); const f32x4* Cr = (const f32x4*)(a.in[I_CRE] + (g * 16 + h) * 64); const f32x4* Ci = (const f32x4*)(a.in[I_CIM] + (g * 16 + h) * 64);
#pragma unroll 2
        for (int p4 = 0; p4 < 16; ++p4) {
            const f32x4 l0 = Lp[2 * p4], l1 = Lp[2 * p4 + 1], cr = Cr[p4], ci = Ci[p4];
            const float lr[4] = {l0.x, l0.z, l1.x, l1.z}, li[4] = {l0.y, l0.w, l1.y, l1.w}, crv[4] = {cr.x, cr.y, cr.z, cr.w}, civ[4] = {ci.x, ci.y, ci.z, ci.w};
#pragma unroll
            for (int e = 0; e < 4; ++e) { const int p = 4 * p4 + e;
                const f32x4 br = *(const f32x4*)(BBR + (g * 64 + p) * 16 + hp0), bi = *(const f32x4*)(BBI + (g * 64 + p) * 16 + hp0);
                acc += crv[e] * (lr[e] * br - li[e] * bi) - civ[e] * (lr[e] * bi + li[e] * br); }
        }
        if (j == 0 && h >= hp0 && h < hp0 + 4) acc[h - hp0] += a.in[I_S5D][g * 16 + h];
        *(f32x4*)(KJ + ((size_t)(g * 8 + j) * 16 + h) * 16 + hp0) = acc;
    }
}
#define LDS_BARRIER() do { asm volatile("s_waitcnt lgkmcnt(0)" ::: "memory"); __builtin_amdgcn_s_barrier(); asm volatile("" ::: "memory"); } while (0)
__device__ __forceinline__ void s5_unit(Frame& F, const Args& a, int unit) {
    unsigned char* ws = a.ws;
    const int g = unit >> 1, half = unit & 1;
    int l_ = F.lane; asm volatile("" : "+v"(l_));
    const int w = F.wave, l = l_, c16 = l & 15, q = l >> 4, tid = w * 64 + l;
    LAS float* SL = (LAS float*)(F.lds);
    LAS bf16* SP = (LAS bf16*)(F.lds + 33792);
    const float2* LAM = (const float2*)(ws + WS_LAM); const float* BBR = (const float*)(ws + WS_BBR); const float* BBI = (const float*)(ws + WS_BBI); const float* KJ = (const float*)(ws + WS_KJ);
    const bf16* Ug = (const bf16*)(ws + WS_UG) + (size_t)g * (MROWS * 16);
    bf16* Gout = (bf16*)(ws + WS_G);
    bf16x8 m2f[4], m13f[8];
    {
        const int n = 16 * w + c16, p = n & 63; const float sgn = (n >= 64) ? 1.f : 0.f;
#pragma unroll
        for (int ks = 0; ks < 4; ++ks) {
            const int tau = 2 * ks + (q >> 1), h0 = 8 * (q & 1);
            const float2 L = LAM[(g * 9 + (7 - tau)) * 64 + p];
            const f32x4 br0 = *(const f32x4*)(BBR + (g * 64 + p) * 16 + h0), br1 = *(const f32x4*)(BBR + (g * 64 + p) * 16 + h0 + 4), bi0 = *(const f32x4*)(BBI + (g * 64 + p) * 16 + h0), bi1 = *(const f32x4*)(BBI + (g * 64 + p) * 16 + h0 + 4);
            const f32x4 A0 = sgn * bi0 + (1.f - sgn) * br0, A1 = sgn * bi1 + (1.f - sgn) * br1, B0 = sgn * br0 - (1.f - sgn) * bi0, B1 = sgn * br1 - (1.f - sgn) * bi1;
            const f32x4 v0 = L.x * A0 + L.y * B0, v1 = L.x * A1 + L.y * B1;
            float v[8] = {v0.x, v0.y, v0.z, v0.w, v1.x, v1.y, v1.z, v1.w};
            m2f[ks] = __builtin_bit_cast(bf16x8, pack8f(v));
            if (ks & 1) asm volatile("" ::: "memory");
        }
#pragma unroll
        for (int ks = 0; ks < 4; ++ks) {
            const int tau = 2 * ks + (q >> 1), h0 = 8 * (q & 1); const float on = (tau <= w) ? 1.f : 0.f; const int jj = (tau <= w) ? (w - tau) : 0;
            const f32x4 k0 = *(const f32x4*)(KJ + ((g * 8 + jj) * 16 + c16) * 16 + h0), k1 = *(const f32x4*)(KJ + ((g * 8 + jj) * 16 + c16) * 16 + h0 + 4);
            float v[8] = {on * k0.x, on * k0.y, on * k0.z, on * k0.w, on * k1.x, on * k1.y, on * k1.z, on * k1.w};
            m13f[ks] = __builtin_bit_cast(bf16x8, pack8f(v));
        }
#pragma unroll
        for (int ks = 4; ks < 8; ++ks) {
            const int kk = 32 * (ks - 4) + 8 * q, p0 = kk & 63; const float sg2 = (kk >= 64) ? 1.f : 0.f;
            const f32x4* Lp = (const f32x4*)(LAM + (g * 9 + (w + 1)) * 64 + p0);
            const f32x4 l0 = Lp[0], l1 = Lp[1], l2 = Lp[2], l3 = Lp[3];
            const f32x4 c0 = *(const f32x4*)(a.in[I_CRE] + (g * 16 + c16) * 64 + p0), c1 = *(const f32x4*)(a.in[I_CRE] + (g * 16 + c16) * 64 + p0 + 4);
            const f32x4 d0 = *(const f32x4*)(a.in[I_CIM] + (g * 16 + c16) * 64 + p0), d1 = *(const f32x4*)(a.in[I_CIM] + (g * 16 + c16) * 64 + p0 + 4);
            const float Lr[8] = {l0.x, l0.z, l1.x, l1.z, l2.x, l2.z, l3.x, l3.z}, Li[8] = {l0.y, l0.w, l1.y, l1.w, l2.y, l2.w, l3.y, l3.w};
            const float cr[8] = {c0.x, c0.y, c0.z, c0.w, c1.x, c1.y, c1.z, c1.w}, ci[8] = {d0.x, d0.y, d0.z, d0.w, d1.x, d1.y, d1.z, d1.w};
            float v[8];
#pragma unroll
            for (int j = 0; j < 8; ++j) { const float re = cr[j] * Lr[j] - ci[j] * Li[j], im = -(cr[j] * Li[j] + ci[j] * Lr[j]); v[j] = sg2 * im + (1.f - sg2) * re; }
            m13f[ks] = __builtin_bit_cast(bf16x8, pack8f(v));
            asm volatile("" ::: "memory");
        }
    }
    const float2 L8 = LAM[(g * 9 + 8) * 64 + l];
    LAS float* LE = (LAS float*)(F.lds + 51200);
    float pwr[8], pwi[8], p8r, p8i;
    { float cr = 1.f, ci = 0.f;
#pragma unroll
      for (int i = 0; i < 8; ++i) { pwr[i] = cr; pwi[i] = ci; const float nr = cr * L8.x - ci * L8.y, ni = cr * L8.y + ci * L8.x; cr = nr; ci = ni; }
      p8r = cr; p8i = ci; }
    float sr = 0.f, si = 0.f;
    LAS bf16* UT = (LAS bf16*)(F.lds + 55296);
    v4u un[2];
#define S5_CROW0(bb) (((bb) == 8) ? (1024 + 64 * half) : ((2 * half + ((bb) >> 2)) * 256 + ((bb) & 3) * 64))
#define S5_LOADU(bb) do { const bf16* ub_ = Ug + (size_t)S5_CROW0(bb) * 128; _Pragma("unroll") for (int i = 0; i < 2; ++i) un[i] = *(const v4u*)(ub_ + (size_t)(tid + 512 * i) * 8); } while (0)
    S5_LOADU(0);
    for (int blk = 0; blk < 9; ++blk) {
        const bool samp = (blk == 8);
        const int bseq = 2 * half + (blk >> 2);
        const int crow0 = S5_CROW0(blk);
#pragma unroll
        for (int i = 0; i < 2; ++i) { const int idx = tid + 512 * i; *(LAS v4u*)(UT + (idx >> 4) * 136 + 8 * (idx & 15)) = un[i]; }
        if (blk < 8) S5_LOADU(blk + 1);
        LDS_BARRIER();
        bf16x8 uf[4][4];
#pragma unroll
        for (int mt = 0; mt < 4; ++mt)
#pragma unroll
            for (int ks = 0; ks < 4; ++ks) uf[mt][ks] = *(const LAS bf16x8*)(UT + (16 * mt + c16) * 136 + 32 * ks + 8 * q);
        f32x4 acc[4];
#pragma unroll
        for (int mt = 0; mt < 4; ++mt) { acc[mt] = (f32x4){0.f, 0.f, 0.f, 0.f};
#pragma unroll
            for (int ks = 0; ks < 4; ++ks) acc[mt] = mfma16(uf[mt][ks], m2f[ks], acc[mt]); }
#pragma unroll
        for (int mt = 0; mt < 4; ++mt)
#pragma unroll
            for (int r = 0; r < 4; ++r) SL[(16 * mt + 4 * q + r) * 132 + 16 * w + c16] = acc[mt][r];
        __syncthreads();
        if (!samp) {
            if ((blk & 3) == 0) { sr = 0.f; si = 0.f; }
            float elr[8], eli[8]; float er = 0.f, ei = 0.f;
#pragma unroll
            for (int i = 0; i < 8; ++i) { elr[i] = er; eli[i] = ei; const float ar = SL[(8 * w + i) * 132 + l], ai = SL[(8 * w + i) * 132 + 64 + l];
                const float nr = L8.x * er - L8.y * ei + ar, ni = L8.x * ei + L8.y * er + ai; er = nr; ei = ni; }
            LE[w * 128 + l] = er; LE[w * 128 + 64 + l] = ei;
            LDS_BARRIER();
            float swr = 0.f, swi = 0.f;
#pragma unroll
            for (int ww = 0; ww < 8; ++ww) { if (ww == w) { swr = sr; swi = si; }
                const float ar = LE[ww * 128 + l], ai = LE[ww * 128 + 64 + l];
                const float nr = p8r * sr - p8i * si + ar, ni = p8r * si + p8i * sr + ai; sr = nr; si = ni; }
#pragma unroll
            for (int i = 0; i < 8; ++i) { SP[(8 * w + i) * 136 + l] = f2bf1(elr[i] + pwr[i] * swr - pwi[i] * swi); SP[(8 * w + i) * 136 + 64 + l] = f2bf1(eli[i] + pwr[i] * swi + pwi[i] * swr); }
            if ((blk & 3) == 3 && w == 0) { a.out[O_PS5RE + (size_t)(bseq * 128 + g) * 64 + l] = sr; a.out[O_PS5IM + (size_t)(bseq * 128 + g) * 64 + l] = si; }
        } else {
#pragma unroll
            for (int it = 0; it < 2; ++it) {
                const int idx = tid + 512 * it, r = idx >> 4, p = 4 * (idx & 15), sb = 64 * half + r;
                const size_t so = (size_t)(sb * 128 + g) * 64 + p;
                const f32x4 s0r = *(const f32x4*)(a.in[I_S5RE] + so), s0i = *(const f32x4*)(a.in[I_S5IM] + so);
                const f32x4 l0 = *(const f32x4*)(LAM + (g * 9 + 8) * 64 + p), l1 = *(const f32x4*)(LAM + (g * 9 + 8) * 64 + p + 2);
                const f32x4 lr = (f32x4){l0.x, l0.z, l1.x, l1.z}, li = (f32x4){l0.y, l0.w, l1.y, l1.w};
                *(LAS unsigned long long*)(SP + r * 136 + p) = (unsigned long long)pk2(s0r.x, s0r.y) | ((unsigned long long)pk2(s0r.z, s0r.w) << 32);
                *(LAS unsigned long long*)(SP + r * 136 + 64 + p) = (unsigned long long)pk2(s0i.x, s0i.y) | ((unsigned long long)pk2(s0i.z, s0i.w) << 32);
                const f32x4 ar = *(const LAS f32x4*)(SL + r * 132 + p), ai = *(const LAS f32x4*)(SL + r * 132 + 64 + p);
                *(f32x4*)(a.out + O_SS5RE + so) = lr * s0r - li * s0i + ar;
                *(f32x4*)(a.out + O_SS5IM + so) = lr * s0i + li * s0r + ai;
            }
        }
        __syncthreads();
#pragma unroll
        for (int mt = 0; mt < 4; ++mt) {
            f32x4 y = (f32x4){0.f, 0.f, 0.f, 0.f};
#pragma unroll
            for (int ks = 0; ks < 4; ++ks) y = mfma16(m13f[ks], uf[mt][ks], y);
#pragma unroll
            for (int ks = 4; ks < 8; ++ks) { const bf16x8 spf = *(const LAS bf16x8*)(SP + (16 * mt + c16) * 136 + 32 * (ks - 4) + 8 * q); y = mfma16(m13f[ks], spf, y); }
            const size_t row = (size_t)8 * (crow0 + 16 * mt + c16) + w;
            const unsigned lo = pk2(gelu_tanh_f(y[0]), gelu_tanh_f(y[1])), hi = pk2(gelu_tanh_f(y[2]), gelu_tanh_f(y[3]));
            *(unsigned long long*)(Gout + row * 2048 + g * 16 + 4 * q) = (unsigned long long)lo | ((unsigned long long)hi << 32);
        }
        __syncthreads();
    }
}
__device__ __forceinline__ void conv_wave_item(Frame& F, const Args& a, int item) {
    unsigned char* ws = a.ws;
    const int cb = item & 31, tb = (item >> 5) & 63, b = item >> 11;
    const int l = F.lane, o = l & 15, seg = l >> 4, col = cb * 128 + 8 * o, t0 = 32 * tb + 8 * seg;
    const bf16* XBC = (const bf16*)(ws + WS_XBC); bf16* XC = (bf16*)(ws + WS_XC);
    const float* cw = a.in[I_CONVW];
    float w[4][8], bias[8];
#pragma unroll
    for (int k = 0; k < 4; ++k) { const f32x4 w0 = *(const f32x4*)(cw + k * 4096 + col), w1 = *(const f32x4*)(cw + k * 4096 + col + 4);
        w[k][0] = w0.x; w[k][1] = w0.y; w[k][2] = w0.z; w[k][3] = w0.w; w[k][4] = w1.x; w[k][5] = w1.y; w[k][6] = w1.z; w[k][7] = w1.w; }
    { const f32x4 b0 = *(const f32x4*)(a.in[I_CONVB] + col), b1 = *(const f32x4*)(a.in[I_CONVB] + col + 4); bias[0] = b0.x; bias[1] = b0.y; bias[2] = b0.z; bias[3] = b0.w; bias[4] = b1.x; bias[5] = b1.y; bias[6] = b1.z; bias[7] = b1.w; }
    const size_t rowbase = (size_t)b * 2048 + t0;
    v4u raw[11];
#pragma unroll
    for (int i = 0; i < 11; ++i) { const int tk = t0 - 3 + i; raw[i] = tk >= 0 ? *(const v4u*)(XBC + (rowbase - 3 + i) * 4096 + col) : (v4u){0u, 0u, 0u, 0u}; }
    if (tb == 63 && seg == 3) {
#pragma unroll
        for (int k = 0; k < 3; ++k) { float r[8]; unpack8(raw[8 + k], r); float* dst = a.out + O_PCONV + (size_t)(b * 3 + k) * 4096 + col;
            *(f32x4*)dst = (f32x4){r[0], r[1], r[2], r[3]}; *(f32x4*)(dst + 4) = (f32x4){r[4], r[5], r[6], r[7]}; }
    }
    float r0[8], r1[8], r2[8], r3[8];
    unpack8(raw[0], r0); unpack8(raw[1], r1); unpack8(raw[2], r2);
#pragma unroll
    for (int r = 0; r < 8; ++r) {
        unpack8(raw[3 + r], r3);
        float v[8];
#pragma unroll
        for (int j = 0; j < 8; ++j) { v[j] = silu_f(bias[j] + w[0][j] * r0[j] + w[1][j] * r1[j] + w[2][j] * r2[j] + w[3][j] * r3[j]); r0[j] = r1[j]; r1[j] = r2[j]; r2[j] = r3[j]; }
        *(v4u*)(XC + (rowbase + r) * 4096 + col) = pack8f(v);
    }
}
__device__ __forceinline__ void dt_wave_item(Frame& F, const Args& a, int item) {
    unsigned char* ws = a.ws; const float* DT = (const float*)(ws + WS_DT); float* DTP = (float*)(ws + WS_DTP);
    const int c = item & 15, head = (item >> 4) & 31, b = item >> 9, l = F.lane, row0 = b * 2048 + 128 * c;
    const float Ah = -expf(a.in[I_ALOG][head]), dtb = a.in[I_DTB][head];
    const float d0 = softplus_f(DT[(size_t)(row0 + 2 * l) * 32 + head] + dtb), d1 = softplus_f(DT[(size_t)(row0 + 2 * l + 1) * 32 + head] + dtb);
    const float a0 = d0 * Ah, a1 = d1 * Ah, s = a0 + a1; float incl = s;
#pragma unroll
    for (int off = 1; off < 64; off <<= 1) { const float vv = __shfl_up(incl, off); if (l >= off) incl += vv; }
    const float ac0 = incl - s + a0, ac1 = incl, last = __shfl(incl, 63);
    float* o = DTP + (size_t)item * 128 + 2 * l;
    *(float2*)o = make_float2(d0, d1); *(float2*)(o + 262144) = make_float2(ac0, ac1); *(float2*)(o + 524288) = make_float2(__expf(last - ac0) * d0, __expf(last - ac1) * d1);
}
__device__ __forceinline__ void ssd_prompt_unit(Frame& F, const Args& a, int unit) {
    unsigned char* ws = a.ws;
    const int xcd = unit & 7, slot = unit >> 3, sub = slot & 7, pg = (slot >> 3) * 8 + xcd;
    const int b = pg >> 3, grp = pg & 7, head = grp * 4 + (sub >> 1), ph = sub & 1;
    const int w = F.wave, l = F.lane, c16 = l & 15, q = l >> 4, tid = F.tid;
    LAS bf16* Bc  = (LAS bf16*)(F.lds);
    LAS bf16* Cc  = (LAS bf16*)(F.lds + 34816);
    LAS bf16* Xr  = (LAS bf16*)(F.lds + 69632);
    LAS bf16* Xw  = (LAS bf16*)(F.lds + 79872);
    LAS bf16* Hb  = (LAS bf16*)(F.lds + 90112);
    LAS float* DTs = (LAS float*)(F.lds + 98816);
    LAS float* ACS = DTs + 128; LAS float* WGT = ACS + 128;
    const bf16* Zb = (const bf16*)(ws + WS_Z); const float* DTP = (const float*)(ws + WS_DTP);
    bf16* YG = (bf16*)(ws + WS_YG); float* SSQP = (float*)(ws + WS_SSQP);
    const float Dh = a.in[I_SSDD][head];
    for (int i = tid; i < 32 * 136; i += 512) Hb[i] = 0;
    f32x4 Hacc[2] = {(f32x4){0.f, 0.f, 0.f, 0.f}, (f32x4){0.f, 0.f, 0.f, 0.f}};
    v4u sb[4], sc[4], sx; unsigned short zq[4][2]; float dr0 = 0.f, dr1 = 0.f, dr2 = 0.f;
    const unsigned offA = (unsigned)((tid >> 4) * 8192 + (tid & 15) * 16), offX = (unsigned)((tid >> 2) * 8192 + (tid & 3) * 16), offZ = (unsigned)((16 * w + 4 * q) * 4096 + c16 * 2), offD = (unsigned)(l * 256);
#define SSD_PREFETCH(cc) do { \
        const char* xc = (const char*)(ws + WS_XC) + ((size_t)(b * 2048 + 128 * (cc)) * 4096 + 2048 + grp * 128) * 2;     \
        const char* xx = (const char*)(ws + WS_XC) + ((size_t)(b * 2048 + 128 * (cc)) * 4096 + head * 64 + ph * 32) * 2; \
        _Pragma("unroll") for (int i = 0; i < 4; ++i) { sb[i] = *(const v4u*)(xc + i * 262144 + offA); sc[i] = *(const v4u*)(xc + i * 262144 + 2048 + offA); } \
        sx = *(const v4u*)(xx + offX); \
        if (tid < 128) { const float* dp = DTP + ((size_t)((b * 32 + head) * 16 + (cc))) * 128 + tid; dr0 = dp[0]; dr1 = dp[262144]; dr2 = dp[524288]; } } while (0)
    SSD_PREFETCH(0);
    asm volatile("" :: "v"(sb[0]), "v"(sb[1]), "v"(sb[2]), "v"(sb[3]), "v"(sc[0]), "v"(sc[1]), "v"(sc[2]), "v"(sc[3]), "v"(sx), "v"(dr0), "v"(dr1), "v"(dr2) : "memory");
    __syncthreads();
    for (int c = 0; c < 16; ++c) {
        const int row0 = b * 2048 + 128 * c;
#pragma unroll
        for (int i = 0; i < 4; ++i) { const int idx = i * 512 + tid, r = idx >> 4, u = idx & 15;
            *(LAS v4u*)(Bc + r * 136 + 8 * u) = sb[i]; *(LAS v4u*)(Cc + r * 136 + 8 * u) = sc[i]; }
        *(LAS v4u*)(Xr + (tid >> 2) * 40 + 8 * (tid & 3)) = sx;
        if (tid < 128) { DTs[tid] = dr0; ACS[tid] = dr1; WGT[tid] = dr2; }
        LDS_BARRIER();
        {
            const char* zb = (const char*)Zb + ((size_t)row0 * 2048 + head * 64 + ph * 32) * 2;
#pragma unroll
            for (int r = 0; r < 4; ++r)
#pragma unroll
                for (int pt = 0; pt < 2; ++pt) zq[r][pt] = *(const unsigned short*)(zb + r * 4096 + pt * 32 + offZ);
        }
        asm volatile("" ::: "memory");
        SSD_PREFETCH(c < 15 ? c + 1 : 15);
        {
            float xr[8]; unpack8(*(const LAS v4u*)(Xr + (tid >> 2) * 40 + 8 * (tid & 3)), xr); const float g = WGT[tid >> 2];
#pragma unroll
            for (int j = 0; j < 8; ++j) xr[j] *= g;
            *(LAS v4u*)(Xw + (tid >> 2) * 40 + 8 * (tid & 3)) = pack8f(xr);
        }
        bf16x8 cf[4];
#pragma unroll
        for (int ks = 0; ks < 4; ++ks) cf[ks] = *(const LAS bf16x8*)(Cc + (16 * w + c16) * 136 + 32 * ks + 8 * q);
        const int lrow = 16 * w + c16; const float acl = ACS[lrow];
        f32x4 yd[2] = {(f32x4){0.f, 0.f, 0.f, 0.f}, (f32x4){0.f, 0.f, 0.f, 0.f}}, yo[2] = {(f32x4){0.f, 0.f, 0.f, 0.f}, (f32x4){0.f, 0.f, 0.f, 0.f}};
#pragma unroll
        for (int Tp = 0; Tp < 4; ++Tp) {
            if (2 * Tp <= w) {
                f32x4 cbt[2] = {(f32x4){0.f, 0.f, 0.f, 0.f}, (f32x4){0.f, 0.f, 0.f, 0.f}};
#pragma unroll
                for (int ks = 0; ks < 4; ++ks) { const bf16x8 bfr = *(const LAS bf16x8*)(Bc + (32 * Tp + c16) * 136 + 32 * ks + 8 * q); cbt[0] = mfma16(bfr, cf[ks], cbt[0]); }
                if (2 * Tp + 1 <= w) {
#pragma unroll
                    for (int ks = 0; ks < 4; ++ks) { const bf16x8 bfr = *(const LAS bf16x8*)(Bc + (32 * Tp + 16 + c16) * 136 + 32 * ks + 8 * q); cbt[1] = mfma16(bfr, cf[ks], cbt[1]); } }
                float e[8];
#pragma unroll
                for (int hf = 0; hf < 2; ++hf) { const int s0 = 16 * (2 * Tp + hf) + 4 * q;
                    const f32x4 as = *(const LAS f32x4*)(ACS + s0), ds = *(const LAS f32x4*)(DTs + s0);
#pragma unroll
                    for (int r = 0; r < 4; ++r) e[4 * hf + r] = (s0 + r <= lrow) ? cbt[hf][r] * __expf(acl - as[r]) * ds[r] : 0.f; }
                const bf16x8 wf = __builtin_bit_cast(bf16x8, pack8f(e));
#pragma unroll
                for (int pt = 0; pt < 2; ++pt) {
                    const unsigned xa = (unsigned)(size_t)Xr + (unsigned)(((32 * Tp + 4 * q + (c16 >> 2)) * 40 + 16 * pt + 4 * (c16 & 3)) * 2);
                    const u16x4_t lo = tr_read(xa), hi = tr_read(xa + 16 * 40 * 2);
                    typedef unsigned short u16x8_t __attribute__((ext_vector_type(8)));
                    const u16x8_t xv = {lo[0], lo[1], lo[2], lo[3], hi[0], hi[1], hi[2], hi[3]};
                    yd[pt] = mfma16(wf, __builtin_bit_cast(bf16x8, xv), yd[pt]); }
            }
        }
#pragma unroll
        for (int pt = 0; pt < 2; ++pt)
#pragma unroll
            for (int ks = 0; ks < 4; ++ks) { const bf16x8 hfr = *(const LAS bf16x8*)(Hb + (16 * pt + c16) * 136 + 32 * ks + 8 * q); yo[pt] = mfma16(cf[ks], hfr, yo[pt]); }
        asm volatile("" :: "v"(sb[0]), "v"(sb[1]), "v"(sb[2]), "v"(sb[3]), "v"(sc[0]), "v"(sc[1]), "v"(sc[2]), "v"(sc[3]), "v"(sx), "v"(dr0), "v"(dr1), "v"(dr2) : "memory");
#pragma unroll
        for (int r = 0; r < 4; ++r) {
            const int lr = 16 * w + 4 * q + r; const float ea = __expf(ACS[lr]); const size_t rowg = (size_t)(row0 + lr); float ss = 0.f;
#pragma unroll
            for (int pt = 0; pt < 2; ++pt) { const int p = 16 * pt + c16; const float xv = bf2f(Xr[lr * 40 + p]);
                const float y = yd[pt][r] + ea * yo[pt][r] + Dh * xv; const float yg = y * silu_f(bf2f(zq[r][pt])); ss += yg * yg; YG[rowg * 2048 + head * 64 + ph * 32 + p] = f2bf1(yg); }
            ss += __shfl_xor(ss, 1); ss += __shfl_xor(ss, 2); ss += __shfl_xor(ss, 4); ss += __shfl_xor(ss, 8);
            if (c16 == 0) SSQP[rowg * 64 + head * 2 + ph] = ss;
        }
        LDS_BARRIER();
        {
            const float dec = __expf(ACS[127]);
            Hacc[0] = Hacc[0] * dec; Hacc[1] = Hacc[1] * dec;
#pragma unroll
            for (int ks = 0; ks < 4; ++ks) {
                const bf16x8 bfr = tr_frag((unsigned)(size_t)Bc, 136, 32 * ks, 16 * w, l);
#pragma unroll
                for (int pt = 0; pt < 2; ++pt) { const bf16x8 xwf = tr_frag((unsigned)(size_t)Xw, 40, 32 * ks, 16 * pt, l); Hacc[pt] = mfma16(xwf, bfr, Hacc[pt]); }
            }
#pragma unroll
            for (int pt = 0; pt < 2; ++pt)
#pragma unroll
                for (int r = 0; r < 4; ++r) Hb[(16 * pt + 4 * q + r) * 136 + 16 * w + c16] = f2bf1(Hacc[pt][r]);
            if (c == 15) {
#pragma unroll
                for (int pt = 0; pt < 2; ++pt)
#pragma unroll
                    for (int r = 0; r < 4; ++r) a.out[O_PSSD + ((size_t)(b * 32 + head) * 64 + ph * 32 + 16 * pt + 4 * q + r) * 128 + 16 * w + c16] = Hacc[pt][r];
            }
        }
        LDS_BARRIER();
    }
    __syncthreads();
#undef SSD_PREFETCH
}
__device__ __forceinline__ bf16x8 cvt8(const f32x4 lo, const f32x4 hi) { v4u w; w.x = pk2(lo.x, lo.y); w.y = pk2(lo.z, lo.w); w.z = pk2(hi.x, hi.y); w.w = pk2(hi.z, hi.w); return __builtin_bit_cast(bf16x8, w); }
__device__ __forceinline__ void ssd_sample_units(Frame& F, const Args& a) {
    unsigned char* ws = a.ws;
    const int w = F.wave, l = F.lane, c16 = l & 15, q = l >> 4, tid = F.tid;
    LAS float* XST = (LAS float*)(F.lds);
    LAS float* BST = XST + 2048;
    LAS float* BS = BST + 1024;
    LAS float* CS = BS + 1024;
    LAS float* YS = CS + 1024;
    LAS float* DTS = YS + 2048;
    LAS float* LAC = DTS + 32;
    LAS float* NWS = LAC + 32;
    const bf16* XBC = (const bf16*)(ws + WS_XBC); const bf16* Zb = (const bf16*)(ws + WS_Z); const float* DT = (const float*)(ws + WS_DT);
    bf16* MIX = (bf16*)(ws + WS_MIX);
    const int hl = w >> 1, pbase = 32 * (w & 1), ch = tid;
    f32x4 Hn[2][8], pnw = (f32x4){0.f, 0.f, 0.f, 0.f}; float pr0 = 0.f, pr1 = 0.f, pr2 = 0.f, pw0 = 0.f, pw1 = 0.f, pw2 = 0.f, pw3 = 0.f, pcb = 0.f, pdt = 0.f, pdb = 0.f, pal = 0.f, pdh = 0.f;
    unsigned short px[8]; unsigned pz[4][2] = {{0u, 0u}, {0u, 0u}, {0u, 0u}, {0u, 0u}};
#define SMP_PREFETCH(uu) do { const int sbn = (uu) >> 3, grpn = (uu) & 7, R0n = MP + 8 * sbn, headn = grpn * 4 + hl; \
        const int coln = ch < 256 ? grpn * 256 + ch : (ch < 384 ? 2048 + grpn * 128 + (ch - 256) : 3072 + grpn * 128 + (ch - 384)); \
        const float* cw = a.in[I_CONVW]; pw0 = cw[coln]; pw1 = cw[4096 + coln]; pw2 = cw[8192 + coln]; pw3 = cw[12288 + coln]; pcb = a.in[I_CONVB][coln]; \
        const float* st = a.in[I_SCONV] + (size_t)sbn * 3 * 4096 + coln; pr0 = st[0]; pr1 = st[4096]; pr2 = st[8192]; \
        _Pragma("unroll") for (int t = 0; t < 8; ++t) px[t] = XBC[(size_t)(R0n + t) * 4096 + coln]; \
        if (tid < 32) { const int hd = grpn * 4 + (tid & 3); pdt = DT[(size_t)(R0n + (tid >> 2)) * 32 + hd]; pdb = a.in[I_DTB][hd]; pal = a.in[I_ALOG][hd]; } \
        _Pragma("unroll") for (int r = 0; r < 4; ++r) { const size_t zo_ = (size_t)(R0n + 4 * (q & 1) + r) * 2048 + headn * 64 + pbase + c16; pz[r][0] = Zb[zo_]; pz[r][1] = Zb[zo_ + 16]; } \
        pdh = a.in[I_SSDD][headn]; pnw = *(const f32x4*)(a.in[I_NORMW] + grpn * 256 + 4 * l); \
        const float* hin = a.in[I_SSSD] + (size_t)(sbn * 32 + headn) * 64 * 128; \
        _Pragma("unroll") for (int pt = 0; pt < 2; ++pt) _Pragma("unroll") for (int ks = 0; ks < 8; ++ks) Hn[pt][ks] = *(const f32x4*)(hin + (size_t)(pbase + 16 * pt + c16) * 128 + 16 * ks + 4 * q); } while (0)
    int u = blockIdx.x;
    if (u < 1024) SMP_PREFETCH(u);
    for (; u < 1024; u += F.G) {
        int l_ = F.lane, t_ = F.tid; asm volatile("" : "+v"(l_), "+v"(t_));
        const int l = l_, c16 = l_ & 15, q = l_ >> 4, tid = t_, ch = t_;
        const int sb = u >> 3, grp = u & 7, R0 = MP + 8 * sb, head = grp * 4 + hl;
        {
            const int col = ch < 256 ? grp * 256 + ch : (ch < 384 ? 2048 + grp * 128 + (ch - 256) : 3072 + grp * 128 + (ch - 384));
            float r0 = pr0, r1 = pr1, r2 = pr2; float cv[8];
#pragma unroll
            for (int t = 0; t < 8; ++t) { const float r3 = bf2f(px[t]);
                cv[t] = silu_f(pcb + pw0 * r0 + pw1 * r1 + pw2 * r2 + pw3 * r3);
                if (t >= 5) a.out[O_SCONV + (size_t)(sb * 3 + (t - 5)) * 4096 + col] = r3;
                r0 = r1; r1 = r2; r2 = r3; }
            if (ch < 256) { *(LAS f32x4*)(XST + ch * 8) = (f32x4){cv[0], cv[1], cv[2], cv[3]}; *(LAS f32x4*)(XST + ch * 8 + 4) = (f32x4){cv[4], cv[5], cv[6], cv[7]}; }
            else if (ch < 384) { const int n = ch - 256; *(LAS f32x4*)(BST + n * 8) = (f32x4){cv[0], cv[1], cv[2], cv[3]}; *(LAS f32x4*)(BST + n * 8 + 4) = (f32x4){cv[4], cv[5], cv[6], cv[7]};
#pragma unroll
                for (int t = 0; t < 8; ++t) BS[t * 128 + n] = cv[t]; }
            else { const int n = ch - 384;
#pragma unroll
                for (int t = 0; t < 8; ++t) CS[t * 128 + n] = cv[t]; }
            if (tid < 32) {
                const float dd = softplus_f(pdt + pdb); float la = -dd * expf(pal);
#pragma unroll
                for (int off = 4; off < 32; off <<= 1) { const float vv = __shfl_up(la, off); if (tid >= off) la += vv; }
                DTS[tid] = dd; LAC[tid] = la; }
        }
        f32x4 H[2][8];
#pragma unroll
        for (int pt = 0; pt < 2; ++pt)
#pragma unroll
            for (int ks = 0; ks < 8; ++ks) H[pt][ks] = Hn[pt][ks];
        unsigned zc[4];
#pragma unroll
        for (int r = 0; r < 4; ++r) zc[r] = pz[r][0] | (pz[r][1] << 16);
        const float Dh = pdh;
        *(LAS f32x4*)(NWS + 4 * tid) = pnw;
        LDS_BARRIER();
        SMP_PREFETCH((u + F.G < 1024) ? u + F.G : u);
        {
            float* hout = a.out + O_SSSD + (size_t)(sb * 32 + head) * 64 * 128;
            const bool act = (q < 2);
            const int tq = 4 * (q & 1);
            const float la7 = LAC[28 + hl], lat = LAC[(c16 & 7) * 4 + hl];
            float las[4], dts[4];
#pragma unroll
            for (int r = 0; r < 4; ++r) { las[r] = LAC[(tq + r) * 4 + hl]; dts[r] = DTS[(tq + r) * 4 + hl]; }
            const f32x4 z4 = (f32x4){0.f, 0.f, 0.f, 0.f};
            bf16x8 Cf[4];
            f32x4 gT = z4;
#pragma unroll
            for (int kb = 0; kb < 4; ++kb) {
                const int trow = (c16 & 7) * 128 + 32 * kb + 4 * q;
                const f32x4 c0 = *(const LAS f32x4*)(CS + trow), c1 = *(const LAS f32x4*)(CS + trow + 16), b0 = *(const LAS f32x4*)(BS + trow), b1 = *(const LAS f32x4*)(BS + trow + 16);
                Cf[kb] = (c16 < 8) ? cvt8(c0, c1) : cvt8(z4, z4);
                const bf16x8 Bf = (c16 < 8) ? cvt8(b0, b1) : cvt8(z4, z4);
                gT = mfma16(Bf, Cf[kb], gT);
            }
            float wv[4];
#pragma unroll
            for (int r = 0; r < 4; ++r) wv[r] = (act && c16 < 8 && tq + r <= c16) ? __expf(lat - las[r]) * dts[r] * gT[r] : 0.f;
            const bf16x8 Wf = cvt8((f32x4){wv[0], wv[1], wv[2], wv[3]}, z4);
            bf16x8 xbf[2], xwf[2];
#pragma unroll
            for (int pt = 0; pt < 2; ++pt) { const f32x4 xr = *(const LAS f32x4*)(XST + (hl * 64 + pbase + 16 * pt + c16) * 8 + tq);
                f32x4 xs, xw;
#pragma unroll
                for (int r = 0; r < 4; ++r) { xs[r] = act ? xr[r] : 0.f; xw[r] = act ? xr[r] * (__expf(la7 - las[r]) * dts[r]) : 0.f; }
                xbf[pt] = cvt8(xs, z4); xwf[pt] = cvt8(xw, z4); }
            asm volatile("" ::: "memory");
            f32x4 yd[2], yo[2];
#pragma unroll
            for (int pt = 0; pt < 2; ++pt) { yd[pt] = mfma16(Wf, xbf[pt], z4); yo[pt] = z4;
#pragma unroll
                for (int kb = 0; kb < 4; ++kb) yo[pt] = mfma16(Cf[kb], cvt8(H[pt][2 * kb], H[pt][2 * kb + 1]), yo[pt]); }
            asm volatile("" ::: "memory");
            if (act) {
#pragma unroll
                for (int pt = 0; pt < 2; ++pt) { const f32x4 xr = *(const LAS f32x4*)(XST + (hl * 64 + pbase + 16 * pt + c16) * 8 + tq);
#pragma unroll
                    for (int r = 0; r < 4; ++r) { const float zf = pt == 0 ? __uint_as_float(zc[r] << 16) : __uint_as_float(zc[r] & 0xffff0000u);
                        YS[(tq + r) * 256 + hl * 64 + pbase + 16 * pt + c16] = (__expf(LAC[(tq + r) * 4 + hl]) * yo[pt][r] + yd[pt][r] + Dh * xr[r]) * silu_f(zf); } }
            }
            asm volatile("" :: "v"((unsigned)px[0]), "v"((unsigned)px[1]), "v"((unsigned)px[2]), "v"((unsigned)px[3]), "v"((unsigned)px[4]), "v"((unsigned)px[5]), "v"((unsigned)px[6]), "v"((unsigned)px[7]),
                         "v"(pr0), "v"(pr1), "v"(pr2), "v"(pw0), "v"(pw1), "v"(pw2), "v"(pw3), "v"(pcb), "v"(pdt), "v"(pdb), "v"(pal), "v"(pdh), "v"(pnw) : "memory");
            asm volatile("" :: "v"(pz[0][0]), "v"(pz[0][1]), "v"(pz[1][0]), "v"(pz[1][1]), "v"(pz[2][0]), "v"(pz[2][1]), "v"(pz[3][0]), "v"(pz[3][1]) : "memory");
            asm volatile("" :: "v"(Hn[0][0]), "v"(Hn[0][1]), "v"(Hn[0][2]), "v"(Hn[0][3]), "v"(Hn[0][4]), "v"(Hn[0][5]), "v"(Hn[0][6]), "v"(Hn[0][7]),
                         "v"(Hn[1][0]), "v"(Hn[1][1]), "v"(Hn[1][2]), "v"(Hn[1][3]), "v"(Hn[1][4]), "v"(Hn[1][5]), "v"(Hn[1][6]), "v"(Hn[1][7]) : "memory");
            const float dec = __expf(la7);
#pragma unroll
            for (int nt = 0; nt < 8; ++nt) {
                const f32x4 bt = *(const LAS f32x4*)(BST + (16 * nt + c16) * 8 + tq);
                f32x4 bs;
#pragma unroll
                for (int r = 0; r < 4; ++r) bs[r] = act ? bt[r] : 0.f;
                const bf16x8 BTf = cvt8(bs, z4);
#pragma unroll
                for (int pt = 0; pt < 2; ++pt) { const f32x4 hn = mfma16(BTf, xwf[pt], H[pt][nt] * dec);
                    *(f32x4*)(hout + (size_t)(pbase + 16 * pt + c16) * 128 + 16 * nt + 4 * q) = hn; }
                asm volatile("" ::: "memory");
            }
        }
        LDS_BARRIER();
        {
            const f32x4 yv = *(const LAS f32x4*)(YS + w * 256 + 4 * l);
            const float ss = wave_sum((yv.x * yv.x + yv.y * yv.y) + (yv.z * yv.z + yv.w * yv.w));
            const float rstd = 1.0f / sqrtf(ss * (1.f / 256.f) + EPS);
            const f32x4 nw = *(const LAS f32x4*)(NWS + 4 * tid);
            *(unsigned long long*)(MIX + (size_t)(R0 + w) * 4096 + 2048 + grp * 256 + 4 * l) = (unsigned long long)pk2(yv.x * rstd * nw.x, yv.y * rstd * nw.y) | ((unsigned long long)pk2(yv.z * rstd * nw.z, yv.w * rstd * nw.w) << 32);
        }
        LDS_BARRIER();
    }
    __syncthreads();
#undef SMP_PREFETCH
}
__device__ __forceinline__ void p3_ssd_norm(Frame& F, const Args& a, int gw, int NGW) {
    unsigned char* ws = a.ws;
    const bf16* YG = (const bf16*)(ws + WS_YG); const float* SSQP = (const float*)(ws + WS_SSQP); bf16* MIX = (bf16*)(ws + WS_MIX);
    const int l = F.lane;
    for (int m = gw; m < MP; m += NGW) {
#pragma unroll
        for (int i = 0; i < 4; ++i) {
            const int c = 8 * (l + 64 * i), grp = c >> 8;
            const f32x4 s0 = *(const f32x4*)(SSQP + (size_t)m * 64 + grp * 8), s1 = *(const f32x4*)(SSQP + (size_t)m * 64 + grp * 8 + 4);
            const float rstd = 1.0f / sqrtf(((s0.x + s0.y) + (s0.z + s0.w) + (s1.x + s1.y) + (s1.z + s1.w)) * (1.f / 256.f) + EPS);
            float v[8]; unpack8(*(const v4u*)(YG + (size_t)m * 2048 + c), v);
            const f32x4 n0 = *(const f32x4*)(a.in[I_NORMW] + c), n1 = *(const f32x4*)(a.in[I_NORMW] + c + 4);
            v[0] *= rstd * n0.x; v[1] *= rstd * n0.y; v[2] *= rstd * n0.z; v[3] *= rstd * n0.w; v[4] *= rstd * n1.x; v[5] *= rstd * n1.y; v[6] *= rstd * n1.z; v[7] *= rstd * n1.w;
            *(v4u*)(MIX + (size_t)m * 4096 + 2048 + c) = pack8f(v);
        }
    }
}
__device__ __forceinline__ f32x4 tail_sum(const float* PART, int m, int j, unsigned lo) {
    const char* p = (const char*)((const bf16*)PART + ((size_t)((m - MP) >> 8) * 16 + j) * 65536 + (size_t)((m - MP) & 255) * 256) + lo;
    const v2u p0 = *(const v2u*)p, p1 = *(const v2u*)(p + (size_t)64 * 131072), p2 = *(const v2u*)(p + (size_t)128 * 131072), p3 = *(const v2u*)(p + (size_t)192 * 131072);
    const f32x4 a0 = (f32x4){__uint_as_float(p0.x << 16), __uint_as_float(p0.x & 0xffff0000u), __uint_as_float(p0.y << 16), __uint_as_float(p0.y & 0xffff0000u)};
    const f32x4 a1 = (f32x4){__uint_as_float(p1.x << 16), __uint_as_float(p1.x & 0xffff0000u), __uint_as_float(p1.y << 16), __uint_as_float(p1.y & 0xffff0000u)};
    const f32x4 a2 = (f32x4){__uint_as_float(p2.x << 16), __uint_as_float(p2.x & 0xffff0000u), __uint_as_float(p2.y << 16), __uint_as_float(p2.y & 0xffff0000u)};
    const f32x4 a3 = (f32x4){__uint_as_float(p3.x << 16), __uint_as_float(p3.x & 0xffff0000u), __uint_as_float(p3.y << 16), __uint_as_float(p3.y & 0xffff0000u)};
    return (a0 + a1) + (a2 + a3);
}
#define ROW_F4(rowp, j) (*(const f32x4*)((const char*)(rowp) + offq[(j) >> 2] + ((j) & 3) * 1024))
#define ROW_H4(rowp, j) (*(const v2u*)((const char*)(rowp) + offh[(j) >> 3] + ((j) & 7) * 512))
#define ROW_F4W(rowp, j) (*(f32x4*)((char*)(rowp) + offq[(j) >> 2] + ((j) & 3) * 1024))
#define ROW_H4W(rowp, j) (*(unsigned long long*)((char*)(rowp) + offh[(j) >> 3] + ((j) & 7) * 512))
__device__ __forceinline__ f32x4 unpk4(const v2u w) { return (f32x4){__uint_as_float(w.x << 16), __uint_as_float(w.x & 0xffff0000u), __uint_as_float(w.y << 16), __uint_as_float(w.y & 0xffff0000u)}; }
__device__ __forceinline__ void p5_row_finish(const LAS unsigned char* glds, f32x4 (&v)[16], const f32x4 (&xv)[16], bf16* x1row, bf16* hnrow, const unsigned (&offq)[4], const unsigned (&offh)[2]) {
    float s = 0.f;
#pragma unroll
    for (int j = 0; j < 16; ++j) s += (v[j].x * v[j].x + v[j].y * v[j].y) + (v[j].z * v[j].z + v[j].w * v[j].w);
    const float rstd1 = 1.0f / sqrtf(wave_sum(s) * (1.f / DM) + EPS); float s2 = 0.f;
#pragma unroll
    for (int j = 0; j < 16; ++j) { if ((j & 3) == 0) asm volatile("" ::: "memory");
        const f32x4 g = *(const LAS f32x4*)(glds + offq[j >> 2] + (j & 3) * 1024);
        v[j] = xv[j] + v[j] * rstd1 * g; s2 += (v[j].x * v[j].x + v[j].y * v[j].y) + (v[j].z * v[j].z + v[j].w * v[j].w);
        ROW_H4W(x1row, j) = (unsigned long long)pk2(v[j].x, v[j].y) | ((unsigned long long)pk2(v[j].z, v[j].w) << 32); }
    const float rstd2 = 1.0f / sqrtf(wave_sum(s2) * (1.f / DM) + EPS);
#pragma unroll
    for (int j = 0; j < 16; ++j) { if ((j & 3) == 0) asm volatile("" ::: "memory");
        const f32x4 g = *(const LAS f32x4*)(glds + 16384 + offq[j >> 2] + (j & 3) * 1024);
        ROW_H4W(hnrow, j) = (unsigned long long)pk2(v[j].x * rstd2 * g.x, v[j].y * rstd2 * g.y) | ((unsigned long long)pk2(v[j].z * rstd2 * g.z, v[j].w * rstd2 * g.w) << 32); }
}
__device__ __forceinline__ void p5_rows(Frame& F, const Args& a) {
    unsigned char* ws = a.ws; const float* PART = (const float*)(ws + WS_PART); const bool split = (F.G == 256);
    const bf16* MIXO = (const bf16*)(ws + WS_MIXO); bf16* HN = (bf16*)(ws + WS_HN);
    const int gw = F.vcu * NWAVES + F.wave, NGW = F.G * NWAVES, l = F.lane;
    unsigned offq[4], offh[2];
#pragma unroll
    for (int k = 0; k < 4; ++k) offq[k] = (unsigned)(l * 16 + 4096 * k);
    offh[0] = (unsigned)(l * 8); offh[1] = (unsigned)(l * 8 + 4096);
    gain_to_lds(F.lds, 0, a.in[I_GPOST], F.tid); gain_to_lds(F.lds, 16384, a.in[I_GFPRE], F.tid);
    __syncthreads();
    const int mend = split ? MP : MROWS;
    v2u mwN[16];
    int m = gw;
    if (m < mend) {
#pragma unroll
        for (int j = 0; j < 16; ++j) mwN[j] = ROW_H4(MIXO + (size_t)m * DM, j); }
    for (; m < mend; m += NGW) {
        f32x4 v[16], xv[16];
        const float* xrow = m < MP ? a.in[I_XP] + (size_t)m * DM : a.in[I_XS] + (size_t)(m - MP) * DM;
#pragma unroll
        for (int j = 0; j < 16; ++j) xv[j] = ROW_F4(xrow, j);
#pragma unroll
        for (int j = 0; j < 16; ++j) v[j] = unpk4(mwN[j]);
        { const int mn = (m + NGW < mend) ? m + NGW : m;
#pragma unroll
            for (int j = 0; j < 16; ++j) mwN[j] = ROW_H4(MIXO + (size_t)mn * DM, j); }
        p5_row_finish(F.lds, v, xv, (bf16*)(ws + WS_X1) + (size_t)m * DM, HN + (size_t)m * DM, offq, offh);
    }
    if (split) for (int mt = MP + gw; mt < MROWS; mt += NGW) {
        f32x4 v[16], xv[16];
#pragma unroll
        for (int j = 0; j < 16; ++j) { v[j] = tail_sum(PART, mt, j, offh[0]); xv[j] = ROW_F4(a.in[I_XS] + (size_t)(mt - MP) * DM, j); }
        p5_row_finish(F.lds, v, xv, (bf16*)(ws + WS_X1) + (size_t)mt * DM, HN + (size_t)mt * DM, offq, offh);
    }
}
__device__ __forceinline__ void p7_conv_geglu(Frame& F, const Args& a) {
    unsigned char* ws = a.ws;
    const bf16* UP = (const bf16*)(ws + WS_UP); bf16* ACT = (bf16*)(ws + WS_ACT);
    const float* cw = a.in[I_FCW]; const float* cb = a.in[I_FCB];
    const int gt = (F.vcu * NWAVES + F.wave) * 64 + F.lane, NT = F.G * NWAVES * 64;
    constexpr int NOC = D_FF / 8, NRB = MROWS / 8;
    const int ngrp = NT / NOC, oc = gt % NOC, grp = gt / NOC;
    if (grp >= ngrp) return;
    const int col = 8 * oc;
    float wg[3][8], wv[3][8], bg[8], bv[8];
#pragma unroll
    for (int j = 0; j < 8; ++j) { bg[j] = cb[col + j]; bv[j] = cb[D_FF + col + j];
#pragma unroll
        for (int k = 0; k < 3; ++k) { wg[k][j] = cw[k * N_UP + col + j]; wv[k][j] = cw[k * N_UP + D_FF + col + j]; } }
    v4u rg[8], rv[8], hh[4];
    const char* upc = (const char*)UP + (size_t)col * 2;
#define P7_ROWP(row) (upc + (size_t)(row) * (N_UP * 2))
#define P7_GLD(dst, p) asm volatile("global_load_dwordx4 %0, %1, off" : "=v"(dst) : "v"(p) : "memory")
#define P7_HALO(row0_) do { const int h2_ = ((row0_) & 2047) ? (row0_) - 2 : (row0_), h1_ = ((row0_) & 2047) ? (row0_) - 1 : (row0_); const char* pa_ = P7_ROWP(h2_); const char* pb_ = P7_ROWP(h1_); \
        P7_GLD(hh[0], pa_); P7_GLD(hh[1], pb_); P7_GLD(hh[2], pa_ + D_FF * 2); P7_GLD(hh[3], pb_ + D_FF * 2); } while (0)
#define P7_ROW(r, row0_) do { float g0[8], v0[8], o[8]; unpack8(rg[r], g0); unpack8(rv[r], v0); \
        _Pragma("unroll") for (int j = 0; j < 8; ++j) { const float gate = bg[j] + wg[0][j] * g2[j] + wg[1][j] * g1[j] + wg[2][j] * g0[j]; const float val = bv[j] + wv[0][j] * v2[j] + wv[1][j] * v1[j] + wv[2][j] * v0[j]; \
            o[j] = gelu_tanh_f(gate) * val; g2[j] = g1[j]; g1[j] = g0[j]; v2[j] = v1[j]; v1[j] = v0[j]; } \
        *(v4u*)(ACT + (size_t)((row0_) + (r)) * D_FF + col) = pack8f(o); } while (0)
    constexpr int NRBP = MP / 8;
#define P7_W8(x) "v"(x[0]), "v"(x[1]), "v"(x[2]), "v"(x[3]), "v"(x[4]), "v"(x[5]), "v"(x[6]), "v"(x[7])
    asm volatile("" :: P7_W8(wg[0]), P7_W8(wg[1]), P7_W8(wg[2]) : "memory");
    asm volatile("" :: P7_W8(wv[0]), P7_W8(wv[1]), P7_W8(wv[2]) : "memory");
    asm volatile("" :: P7_W8(bg), P7_W8(bv) : "memory");
#undef P7_W8
    asm volatile("s_waitcnt vmcnt(0)" ::: "memory");
    {
        const int rb0 = grp < NRBP ? grp : 0;
        P7_HALO(8 * rb0);
#pragma unroll
        for (int r = 0; r < 8; ++r) { const char* pr_ = P7_ROWP(8 * rb0 + r); P7_GLD(rg[r], pr_); P7_GLD(rv[r], pr_ + D_FF * 2); }
    }
    int rb = grp;
#pragma unroll 1
    for (; rb < NRBP; rb += ngrp) {
        const int row0 = 8 * rb, rown = (rb + ngrp < NRBP) ? row0 + 8 * ngrp : row0;
        float g2[8], g1[8], v2[8], v1[8];
        asm volatile("s_waitcnt vmcnt(16)" : "+v"(hh[0]), "+v"(hh[1]), "+v"(hh[2]), "+v"(hh[3]) :: "memory");
        unpack8(hh[0], g2); unpack8(hh[1], g1); unpack8(hh[2], v2); unpack8(hh[3], v1);
        const float keep = (row0 & 2047) ? 1.f : 0.f;
#pragma unroll
        for (int j = 0; j < 8; ++j) { g2[j] *= keep; g1[j] *= keep; v2[j] *= keep; v1[j] *= keep; }
        asm volatile("" :: "v"(g2[0]), "v"(g2[1]), "v"(g2[2]), "v"(g2[3]), "v"(g2[4]), "v"(g2[5]), "v"(g2[6]), "v"(g2[7]), "v"(g1[0]), "v"(g1[1]), "v"(g1[2]), "v"(g1[3]), "v"(g1[4]), "v"(g1[5]), "v"(g1[6]), "v"(g1[7]) : "memory");
        asm volatile("" :: "v"(v2[0]), "v"(v2[1]), "v"(v2[2]), "v"(v2[3]), "v"(v2[4]), "v"(v2[5]), "v"(v2[6]), "v"(v2[7]), "v"(v1[0]), "v"(v1[1]), "v"(v1[2]), "v"(v1[3]), "v"(v1[4]), "v"(v1[5]), "v"(v1[6]), "v"(v1[7]) : "memory");
        P7_HALO(rown);
#pragma unroll
        for (int r = 0; r < 8; ++r) {
            float g0[8], v0[8], o[8];
            asm volatile("s_waitcnt vmcnt(%2)" : "+v"(rg[r]), "+v"(rv[r]) : "n"(18 + r) : "memory");
            unpack8(rg[r], g0); unpack8(rv[r], v0);
            asm volatile("" :: "v"(g0[0]), "v"(g0[1]), "v"(g0[2]), "v"(g0[3]), "v"(g0[4]), "v"(g0[5]), "v"(g0[6]), "v"(g0[7]), "v"(v0[0]), "v"(v0[1]), "v"(v0[2]), "v"(v0[3]), "v"(v0[4]), "v"(v0[5]), "v"(v0[6]), "v"(v0[7]) : "memory");
            { const char* pr_ = P7_ROWP(rown + r); P7_GLD(rg[r], pr_); P7_GLD(rv[r], pr_ + D_FF * 2); }
#pragma unroll
            for (int j = 0; j < 8; ++j) { const float gate = bg[j] + wg[0][j] * g2[j] + wg[1][j] * g1[j] + wg[2][j] * g0[j]; const float val = bv[j] + wv[0][j] * v2[j] + wv[1][j] * v1[j] + wv[2][j] * v0[j];
                o[j] = gelu_tanh_f(gate) * val; g2[j] = g1[j]; g1[j] = g0[j]; v2[j] = v1[j]; v1[j] = v0[j]; }
            *(v4u*)(ACT + (size_t)(row0 + r) * D_FF + col) = pack8f(o);
        }
    }
    asm volatile("s_waitcnt vmcnt(0)" ::: "memory");
#pragma unroll 1
    for (; rb < NRB; rb += ngrp) {
        const int row0 = 8 * rb;
#pragma unroll
        for (int r = 0; r < 8; ++r) { rg[r] = *(const v4u*)P7_ROWP(row0 + r); rv[r] = *(const v4u*)(P7_ROWP(row0 + r) + D_FF * 2); }
        float g2[8], g1[8], v2[8], v1[8];
        const float* st = a.in[I_SFFN] + (size_t)((row0 - MP) >> 3) * 2 * N_UP + col;
#pragma unroll
        for (int h = 0; h < 2; ++h) { const f32x4 a2 = *(const f32x4*)(st + 4 * h), a1 = *(const f32x4*)(st + N_UP + 4 * h), b2 = *(const f32x4*)(st + D_FF + 4 * h), b1 = *(const f32x4*)(st + N_UP + D_FF + 4 * h);
#pragma unroll
            for (int j = 0; j < 4; ++j) { g2[4 * h + j] = a2[j]; g1[4 * h + j] = a1[j]; v2[4 * h + j] = b2[j]; v1[4 * h + j] = b1[j]; } }
#pragma unroll
        for (int r = 0; r < 8; ++r) P7_ROW(r, row0);
    }
#undef P7_ROWP
#undef P7_GLD
#undef P7_HALO
#undef P7_ROW
}
__device__ __forceinline__ void p9_rows(Frame& F, const Args& a) {
    unsigned char* ws = a.ws; const float* PART = (const float*)(ws + WS_PART); const bool split = (F.G == 256);
    const bf16* FFb = (const bf16*)(ws + WS_FF);
    const int gw = F.vcu * NWAVES + F.wave, NGW = F.G * NWAVES, l = F.lane;
    gain_to_lds(F.lds, 0, a.in[I_GFPOST], F.tid);
    __syncthreads();
    for (int m = gw; m < MROWS; m += NGW) {
        f32x4 v[16], x1[16]; float s = 0.f;
        const bool tail = split && m >= MP;
        const v2u* xrow = (const v2u*)((const bf16*)(ws + WS_X1) + (size_t)m * DM);
#pragma unroll
        for (int j = 0; j < 16; ++j) { const v2u xw = xrow[l + 64 * j];
            x1[j] = (f32x4){__uint_as_float(xw.x << 16), __uint_as_float(xw.x & 0xffff0000u), __uint_as_float(xw.y << 16), __uint_as_float(xw.y & 0xffff0000u)}; }
#pragma unroll
        for (int j = 0; j < 16; ++j) {
            if (tail) v[j] = tail_sum(PART, m, j, (unsigned)(l * 8));
            else { const v2u mw = *(const v2u*)(FFb + (size_t)m * DM + 4 * (l + 64 * j));
                v[j] = (f32x4){__uint_as_float(mw.x << 16), __uint_as_float(mw.x & 0xffff0000u), __uint_as_float(mw.y << 16), __uint_as_float(mw.y & 0xffff0000u)}; }
            s += (v[j].x * v[j].x + v[j].y * v[j].y) + (v[j].z * v[j].z + v[j].w * v[j].w); }
        const float rstd = 1.0f / sqrtf(wave_sum(s) * (1.f / DM) + EPS);
        f32x4* orow = (f32x4*)(a.out + O_Y + (size_t)m * DM);
#pragma unroll
        for (int j = 0; j < 16; ++j) { const f32x4 g = ((const LAS f32x4*)F.lds)[l + 64 * j]; orow[l + 64 * j] = x1[j] + v[j] * rstd * g; }
    }
}

__global__ void __launch_bounds__(NWAVES * 64, 2) mk_fwd(Args args) {
    extern __shared__ __attribute__((aligned(16))) unsigned char lds[];
    Frame F;
    F.lds = (LAS unsigned char*)lds;
    volatile LAS unsigned* MISC = (volatile LAS unsigned*)(F.lds + MISC_OFF);
    F.tid = threadIdx.x; F.lane = F.tid & 63; F.wave = __builtin_amdgcn_readfirstlane(F.tid >> 6);
    F.G = gridDim.x; { const int bx = blockIdx.x; F.vcu = (F.G % 8 == 0) ? (bx % 8) * (F.G / 8) + bx / 8 : bx; }
    unsigned char* ws = args.ws;
    unsigned* ctl = (unsigned*)(ws + WS_CTL);
    for (int u = F.tid; u < (LDS_BYTES - MISC_OFF) / 4; u += NWAVES * 64) ((LAS unsigned*)(F.lds + MISC_OFF))[u] = 0u;
    __syncthreads();
    XcdBarrier bar = xcd_barrier_post(ctl + CW_BAR + args.bli * XCD_BAR_WORDS, MISC + 8);
    const int lo = args.ph_lo, hi = args.ph_hi;
#define IN(k) (lo <= (k) && (k) < hi)
#define SEAM(k) do { if (IN(k) && IN((k) + 1)) xcd_barrier(bar); } while (0)

    if (IN(0)) { p0_prologue(F, args); } SEAM(0);
    if (IN(1)) {
        pg8::Gemm g{(const pg8::bf16_t*)(ws + WS_HN), (const pg8::bf16_t*)(ws + WS_WIN), MROWS, N1PAD, DM}; pg8::StaticOrder S; S.init(MROWS, N1PAD, F.G, (int)blockIdx.x, DM);
        pg8::EpiProj E{(pg8::bf16_t*)(ws + WS_UG), (pg8::bf16_t*)(ws + WS_Z), (pg8::bf16_t*)(ws + WS_XBC), (float*)(ws + WS_DT), MROWS};
        pg8::gemm_phase<pg8::EpiProj, pg8::StaticOrder, false, true>(F.lds, g, S, E);
        {
            constexpr int NB1 = ((MROWS / 256) * (N1PAD / 256)) % 256;
            if (F.G == 256) { if ((int)blockIdx.x >= NB1) p1_kj(F, args, ((int)blockIdx.x - NB1) * NWAVES + F.wave, (256 - NB1) * NWAVES); }
            else p1_kj(F, args, F.vcu * NWAVES + F.wave, F.G * NWAVES);
        }
        convert_fill(F, args, (MROWS / 256) * (N1PAD / 256), 1, 0, CV_GL); convert_fill(F, args, (MROWS / 256) * (N1PAD / 256), 2, 0, CV_OUT); if (!(args.pad & 2048)) convert_fill(F, args, (MROWS / 256) * (N1PAD / 256), 3, 0, CV_UP_P1);
    } SEAM(1);
    if (IN(2)) {
        const int msk = args.pad ? args.pad : 15;
        if (msk & 1) for (int u = (int)blockIdx.x * NWAVES + F.wave; u < 8192; u += F.G * NWAVES) conv_wave_item(F, args, u);
        if (msk & 1) for (int u = (int)blockIdx.x * NWAVES + F.wave; u < 2048; u += F.G * NWAVES) dt_wave_item(F, args, u);
        __syncthreads();
        if (msk & 2) for (int u = blockIdx.x; u < 256; u += F.G) s5_unit(F, args, u);
        xcd_barrier(bar);
        if (msk & 4) for (int u = blockIdx.x; u < 256; u += F.G) ssd_prompt_unit(F, args, u);
        if (msk & 8) ssd_sample_units(F, args);
    } SEAM(2);
    if (IN(3)) {
        pg8::Gemm g{(const pg8::bf16_t*)(ws + WS_G), (const pg8::bf16_t*)(ws + WS_WGLU), MROWS, 2048, 2048}; pg8::StaticOrder S; S.init(MROWS, 2048, F.G, (int)blockIdx.x, 2048);
        pg8::EpiGlu E{(const pg8::bf16_t*)(ws + WS_G), args.in[I_BGLU], (pg8::bf16_t*)(ws + WS_MIX)};
        pg8::gemm_phase<pg8::EpiGlu, pg8::StaticOrder, false, true>(F.lds, g, S, E);
        convert_fill(F, args, (MROWS / 256) * (2048 / 256), 3, CV_UP_P1, CV_UP_P1 + CV_UP_TAIL);
        {
            constexpr int NB = ((MROWS / 256) * (2048 / 256)) % 256;
            if (F.G == 256) { if ((int)blockIdx.x >= NB) p3_ssd_norm(F, args, ((int)blockIdx.x - NB) * NWAVES + F.wave, (256 - NB) * NWAVES); }
            else p3_ssd_norm(F, args, F.vcu * NWAVES + F.wave, F.G * NWAVES);
        }
    } SEAM(3);
    if (IN(4)) {
        pg8::Gemm g{(const pg8::bf16_t*)(ws + WS_MIX), (const pg8::bf16_t*)(ws + WS_WOUT), MROWS, DM, DM}; pg8::TailSplitOrder S; S.init(MROWS, MP, DM, F.G, (int)blockIdx.x, DM);
        pg8::EpiSplit<pg8::EpiStoreBf16> E{pg8::EpiStoreBf16{(pg8::bf16_t*)(ws + WS_MIXO), DM}, (float*)(ws + WS_PART)};
        pg8::gemm_phase<pg8::EpiSplit<pg8::EpiStoreBf16>, pg8::TailSplitOrder, false, true>(F.lds, g, S, E);
    } SEAM(4);
    if (IN(5)) { p5_rows(F, args); } SEAM(5);

    if (IN(6)) {
        pg8::Gemm g{(const pg8::bf16_t*)(ws + WS_HN), (const pg8::bf16_t*)(ws + WS_WUP), MROWS, N_UP, DM}; pg8::StaticOrder S; S.init(MROWS, N_UP, F.G, (int)blockIdx.x, DM);
        pg8::EpiUp E{(pg8::bf16_t*)(ws + WS_UP), args.out + O_PFFN, args.out + O_SFFN};
        pg8::gemm_phase<pg8::EpiUp, pg8::StaticOrder, false, true>(F.lds, g, S, E);
        convert_fill(F, args, (MROWS / 256) * (N_UP / 256), 4, 0, CV_DN);
    } SEAM(6);
    if (IN(7)) { p7_conv_geglu(F, args); } SEAM(7);
    if (IN(8)) {
        pg8::Gemm g{(const pg8::bf16_t*)(ws + WS_ACT), (const pg8::bf16_t*)(ws + WS_WDN), MROWS, DM, D_FF}; pg8::TailSplitOrder S; S.init(MROWS, MP, DM, F.G, (int)blockIdx.x, D_FF);
        pg8::EpiSplit<pg8::EpiStoreBf16> E{pg8::EpiStoreBf16{(pg8::bf16_t*)(ws + WS_FF), DM}, (float*)(ws + WS_PART)};
        pg8::gemm_phase<pg8::EpiSplit<pg8::EpiStoreBf16>, pg8::TailSplitOrder, false, true>(F.lds, g, S, E);
    } SEAM(8);
    if (IN(9)) { p9_rows(F, args); }
#ifdef MK_PROBE_GEMM
    if (IN(10)) {
        pg8::Gemm g{(const pg8::bf16_t*)(ws + WS_HN), (const pg8::bf16_t*)(ws + WS_WUP), MROWS, N_UP, DM}; pg8::SameTileOrder S; S.s.init(MROWS, N_UP, F.G, (int)blockIdx.x, DM);
        pg8::EpiStoreBf16 E{(pg8::bf16_t*)(ws + WS_ACT), N_UP};
        pg8::gemm_phase<pg8::EpiStoreBf16, pg8::SameTileOrder, true, true>(F.lds, g, S, E);
    }
#endif
#undef IN
#undef SEAM
}

extern "C" void kernel_launch(void* const* d_in, const int* in_sizes, int n_in, void* d_out, int out_size, void* d_ws, size_t ws_size, hipStream_t stream) {
    static int grid = 0;
    if (grid == 0) {
        if (n_in != 33 || (size_t)out_size != O_END || ws_size < WS_END) { fprintf(stderr, "kernel_launch: unexpected shapes: n_in %d out %d ws %zu (need %zu); nothing launched\n", n_in, out_size, ws_size, (size_t)WS_END); grid = -1; return; }
        int dev = 0, cus = 0, per_cu = 0;
        if (hipGetDevice(&dev) != hipSuccess || hipDeviceGetAttribute(&cus, hipDeviceAttributeMultiprocessorCount, dev) != hipSuccess) { grid = -1; return; }
        if (hipFuncSetAttribute((const void*)mk_fwd, hipFuncAttributeMaxDynamicSharedMemorySize, LDS_BYTES) != hipSuccess) { fprintf(stderr, "kernel_launch: hipFuncSetAttribute failed\n"); grid = -1; return; }
        if (hipOccupancyMaxActiveBlocksPerMultiprocessor(&per_cu, (const void*)mk_fwd, NWAVES * 64, LDS_BYTES) != hipSuccess || per_cu < 1) { fprintf(stderr, "kernel_launch: occupancy query says %d blocks per CU\n", per_cu); per_cu = 1; }
        (void)hipGetLastError();
        grid = cus;
    }
    if (grid < 0) return;
    if (hipMemsetAsync((char*)d_ws + WS_CTL, 0, CTL_ZERO_BYTES, stream) != hipSuccess) return;
    Args a{};
    for (int i = 0; i < 33; ++i) a.in[i] = (const float*)d_in[i];
    a.out = (float*)d_out; a.ws = (unsigned char*)d_ws;
#ifndef MK_LAUNCHES
#define MK_LAUNCHES {0, MK_PH_HI, 0}
#endif
    {
        const int ex[][3] = { MK_LAUNCHES };
        for (int e = 0; e < (int)(sizeof(ex) / sizeof(ex[0])); ++e) { a.ph_lo = ex[e][0]; a.ph_hi = ex[e][1]; a.bli = e; a.pad = ex[e][2]; hipLaunchKernelGGL(mk_fwd, dim3(grid), dim3(NWAVES * 64), LDS_BYTES, stream, a); }
    }
    const hipError_t le = hipPeekAtLastError();
    if (le != hipSuccess) fprintf(stderr, "kernel_launch: launch failed: %s\n", hipGetErrorName(le));
}
```
